# Optimizing an MI355X kernel written in HIP

```python
import jax, jax.numpy as jnp
from jax import lax
import numpy as np

D_MODEL = 1024
BATCH = 8
SEQ = 4096
DEPTH = 2

CHUNK = 64
N_MIXERS = 2
EPS = 1e-6

RET_HEADS = 4
RET_DK = D_MODEL // RET_HEADS
RET_DV = 2 * RET_DK
RET_QK_DIM = RET_HEADS * RET_DK
RET_V_DIM = RET_HEADS * RET_DV
RET_IN_DIM = 2 * RET_QK_DIM + 2 * RET_V_DIM
ROPE_BASE = 10000.0

POOL_WINDOWS = (2, 4, 8, 16)
POOL_GROUPS = len(POOL_WINDOWS)
POOL_GROUP_DIM = D_MODEL // POOL_GROUPS

MOE_GROUPS = 4
MOE_EXPERTS_PER_GROUP = 8
MOE_EXPERTS = MOE_GROUPS * MOE_EXPERTS_PER_GROUP
MOE_TOP_K = 2
MOE_D_FF = 256
MOE_BLOCK_ROWS = 128

kernel_name = "hybrid_retention_pool_hier_moe"


def rmsnorm(x, gain):
    xf = x.astype(jnp.float32)
    inv = lax.rsqrt(jnp.mean(xf * xf, axis=-1, keepdims=True) + EPS)
    return (xf * inv * gain.astype(jnp.float32)).astype(x.dtype)


def rope(x, pos):
    half = x.shape[-1] // 2
    inv_freq = 1.0 / (ROPE_BASE ** (jnp.arange(half, dtype=jnp.float32) / half))
    ang = pos[:, None] * inv_freq[None, :]
    cos = jnp.cos(ang)[None, :, None, :]
    sin = jnp.sin(ang)[None, :, None, :]
    x1, x2 = x[..., :half], x[..., half:]
    return jnp.concatenate([x1 * cos - x2 * sin, x1 * sin + x2 * cos], axis=-1)


def chunk_retention(q, k, v):
    B, H, S, dk = q.shape
    dv = v.shape[-1]
    n_chunks = S // CHUNK
    log_g = jnp.log(1.0 - jnp.exp2(-5.0 - jnp.arange(H, dtype=jnp.float32)))[:, None]
    j = jnp.arange(CHUNK, dtype=jnp.float32)
    intra_decay = jnp.exp(log_g[:, :, None] * jnp.abs(j[:, None] - j[None, :]))
    q_dec = jnp.exp(log_g * (j + 1.0))[None, :, :, None]
    k_dec = jnp.exp(log_g * (CHUNK - 1.0 - j))[None, :, :, None]
    chunk_dec = jnp.exp(log_g * CHUNK)[None, :, :, None]

    qc = q.reshape(B, H, n_chunks, CHUNK, dk)
    kc = k.reshape(B, H, n_chunks, CHUNK, dk)
    vc = v.reshape(B, H, n_chunks, CHUNK, dv)
    scores = jnp.einsum('bhncd,bhnmd->bhncm', qc, kc) * intra_decay[None, :, None]
    intra = jnp.einsum('bhncm,bhnme->bhnce', scores, vc)

    def step(state, inp):
        qn, kn, vn = inp
        cross = jnp.einsum('bhcd,bhde->bhce', qn * q_dec, state)
        state = state * chunk_dec + jnp.einsum('bhcd,bhce->bhde', kn * k_dec, vn)
        return state, cross

    xs = (jnp.moveaxis(qc, 2, 0), jnp.moveaxis(kc, 2, 0), jnp.moveaxis(vc, 2, 0))
    state0 = jnp.zeros((B, H, dk, dv), jnp.float32)
    _, cross = lax.scan(step, state0, xs)
    out = intra + jnp.moveaxis(cross, 0, 2)
    return out.reshape(B, H, S, dv)


def retention_mixer(h, w_in, w_out):
    B, S, _ = h.shape
    proj = h @ w_in
    q = proj[..., :RET_QK_DIM].astype(jnp.float32).reshape(B, S, RET_HEADS, RET_DK)
    k = proj[..., RET_QK_DIM:2 * RET_QK_DIM].astype(jnp.float32).reshape(B, S, RET_HEADS, RET_DK)
    v = proj[..., 2 * RET_QK_DIM:2 * RET_QK_DIM + RET_V_DIM].astype(jnp.float32).reshape(B, S, RET_HEADS, RET_DV)
    g = proj[..., 2 * RET_QK_DIM + RET_V_DIM:].astype(jnp.float32)
    pos = jnp.arange(S, dtype=jnp.float32)
    q = rope(q, pos)
    k = rope(k, pos) * (RET_DK ** -0.5)
    o = chunk_retention(q.transpose(0, 2, 1, 3), k.transpose(0, 2, 1, 3), v.transpose(0, 2, 1, 3))
    mu = jnp.mean(o, axis=-1, keepdims=True)
    var = jnp.mean(jnp.square(o - mu), axis=-1, keepdims=True)
    o = (o - mu) * lax.rsqrt(var + EPS)
    o = o.transpose(0, 2, 1, 3).reshape(B, S, RET_V_DIM)
    return (jax.nn.silu(g) * o).astype(h.dtype) @ w_out


def pool_mixer(h, w_group, scale):
    B, S, D = h.shape
    hg = h.astype(jnp.float32).reshape(B, S, POOL_GROUPS, POOL_GROUP_DIM)
    cs = jnp.concatenate([jnp.zeros((B, 1, POOL_GROUPS, POOL_GROUP_DIM), jnp.float32),
                          jnp.cumsum(hg, axis=1)], axis=1)
    t = jnp.arange(S)[:, None]
    win = jnp.array(POOL_WINDOWS, dtype=jnp.int32)[None, :]
    lo = jnp.maximum(t + 1 - win, 0)
    cnt = (t + 1 - lo).astype(jnp.float32)
    gidx = jnp.arange(POOL_GROUPS)[None, :]
    window_sum = cs[:, 1:] - cs[:, lo, gidx]
    pooled = window_sum / cnt[None, :, :, None] - hg
    y = jnp.einsum('bsgc,gcd->bsgd', pooled.astype(h.dtype), w_group).reshape(B, S, D)
    return y * scale


def hier_moe(h, w_group_router, b_group_router, w_expert_router, b_expert_router,
             w_gate, w_up, w_down):
    B, S, D = h.shape
    T = B * S
    xf = h.reshape(T, D)
    g_logits = (xf @ w_group_router).astype(jnp.float32) + b_group_router.astype(jnp.float32)
    g_prob = jax.nn.softmax(g_logits, axis=-1)
    grp = jnp.argmax(g_logits, axis=-1)
    g_gate = jnp.take_along_axis(g_prob, grp[:, None], axis=-1)
    e_logits = (xf @ w_expert_router).astype(jnp.float32).reshape(T, MOE_GROUPS, MOE_EXPERTS_PER_GROUP)
    e_logits = e_logits + b_expert_router.astype(jnp.float32)[None]
    e_sel = jnp.take_along_axis(e_logits, grp[:, None, None], axis=1)[:, 0]
    top_p, top_i = lax.top_k(jax.nn.softmax(e_sel, axis=-1), MOE_TOP_K)
    top_p = top_p / jnp.sum(top_p, axis=-1, keepdims=True)
    weights = g_gate * top_p
    expert = grp[:, None] * MOE_EXPERTS_PER_GROUP + top_i

    P = T * MOE_TOP_K
    n_blocks = -(-P // MOE_BLOCK_ROWS) + MOE_EXPERTS
    e_flat = expert.reshape(P)
    tok_flat = jnp.repeat(jnp.arange(T, dtype=jnp.int32), MOE_TOP_K)
    w_flat = weights.reshape(P)
    order = jnp.argsort(e_flat)
    e_s, tok_s, w_s = e_flat[order], tok_flat[order], w_flat[order]
    counts = jax.ops.segment_sum(jnp.ones((P,), jnp.int32), e_flat, num_segments=MOE_EXPERTS)
    starts = jnp.cumsum(counts) - counts
    padded = ((counts + MOE_BLOCK_ROWS - 1) // MOE_BLOCK_ROWS) * MOE_BLOCK_ROWS
    pad_ends = jnp.cumsum(padded)
    pad_starts = pad_ends - padded
    dest = pad_starts[e_s] + (jnp.arange(P, dtype=jnp.int32) - starts[e_s])
    buf_tok = jnp.full((n_blocks * MOE_BLOCK_ROWS,), T, jnp.int32).at[dest].set(tok_s)
    buf_w = jnp.zeros((n_blocks * MOE_BLOCK_ROWS,), jnp.float32).at[dest].set(w_s)
    blk_start = jnp.arange(n_blocks, dtype=jnp.int32) * MOE_BLOCK_ROWS
    blk_expert = jnp.minimum(jnp.searchsorted(pad_ends, blk_start, side='right'), MOE_EXPERTS - 1)
    x_pad = jnp.concatenate([xf, jnp.zeros((1, D), xf.dtype)], axis=0)

    def run_block(args):
        idx, e = args
        xb = x_pad[idx]
        hid = jax.nn.silu(xb @ w_gate[e]) * (xb @ w_up[e])
        return hid @ w_down[e]

    ys = lax.map(run_block, (buf_tok.reshape(n_blocks, MOE_BLOCK_ROWS), blk_expert))
    ys = ys * buf_w.reshape(n_blocks, MOE_BLOCK_ROWS, 1).astype(ys.dtype)
    out = jnp.zeros((T + 1, D), xf.dtype).at[buf_tok].add(ys.reshape(-1, D))[:T]
    return out.reshape(B, S, D)


def setup_inputs(seed: int = 0) -> dict:
    key = jax.random.key(seed)
    ks = jax.random.split(key, 16)
    n_ret = (DEPTH + N_MIXERS - 1) // N_MIXERS
    n_pool = DEPTH // N_MIXERS
    nrm = jax.random.normal
    x = nrm(ks[0], (BATCH, SEQ, D_MODEL), jnp.float32)
    norm_mix = 1.0 + 0.02 * nrm(ks[1], (DEPTH, D_MODEL), jnp.float32)
    norm_ffn = 1.0 + 0.02 * nrm(ks[2], (DEPTH, D_MODEL), jnp.float32)
    ret_w_in = nrm(ks[3], (n_ret, D_MODEL, RET_IN_DIM), jnp.float32) * D_MODEL ** -0.5
    ret_w_out = nrm(ks[4], (n_ret, RET_V_DIM, D_MODEL), jnp.float32) * RET_V_DIM ** -0.5
    pool_w = nrm(ks[5], (n_pool, POOL_GROUPS, POOL_GROUP_DIM, POOL_GROUP_DIM), jnp.float32) * POOL_GROUP_DIM ** -0.5
    pool_scale = 0.5 + 0.1 * nrm(ks[6], (n_pool, D_MODEL), jnp.float32)
    moe_w_group = nrm(ks[7], (DEPTH, D_MODEL, MOE_GROUPS), jnp.float32) * D_MODEL ** -0.5
    moe_b_group = 0.01 * nrm(ks[8], (DEPTH, MOE_GROUPS), jnp.float32)
    moe_w_expert = nrm(ks[9], (DEPTH, D_MODEL, MOE_EXPERTS), jnp.float32) * D_MODEL ** -0.5
    moe_b_expert = 0.01 * nrm(ks[10], (DEPTH, MOE_GROUPS, MOE_EXPERTS_PER_GROUP), jnp.float32)
    moe_w_gate = nrm(ks[11], (DEPTH, MOE_EXPERTS, D_MODEL, MOE_D_FF), jnp.float32) * D_MODEL ** -0.5
    moe_w_up = nrm(ks[12], (DEPTH, MOE_EXPERTS, D_MODEL, MOE_D_FF), jnp.float32) * D_MODEL ** -0.5
    moe_w_down = nrm(ks[13], (DEPTH, MOE_EXPERTS, MOE_D_FF, D_MODEL), jnp.float32) * MOE_D_FF ** -0.5
    final_norm = 1.0 + 0.02 * nrm(ks[14], (D_MODEL,), jnp.float32)
    return {"x": x, "norm_mix": norm_mix, "norm_ffn": norm_ffn,
            "ret_w_in": ret_w_in, "ret_w_out": ret_w_out,
            "pool_w": pool_w, "pool_scale": pool_scale,
            "moe_w_group": moe_w_group, "moe_b_group": moe_b_group,
            "moe_w_expert": moe_w_expert, "moe_b_expert": moe_b_expert,
            "moe_w_gate": moe_w_gate, "moe_w_up": moe_w_up, "moe_w_down": moe_w_down,
            "final_norm": final_norm}


def reference(x, norm_mix, norm_ffn, ret_w_in, ret_w_out, pool_w, pool_scale,
              moe_w_group, moe_b_group, moe_w_expert, moe_b_expert,
              moe_w_gate, moe_w_up, moe_w_down, final_norm):
    for layer in range(DEPTH):
        h = rmsnorm(x, norm_mix[layer])
        slot = layer // N_MIXERS
        if layer % N_MIXERS == 0:
            y = retention_mixer(h, ret_w_in[slot], ret_w_out[slot])
        else:
            y = pool_mixer(h, pool_w[slot], pool_scale[slot])
        x = x + y
        h = rmsnorm(x, norm_ffn[layer])
        x = x + hier_moe(h, moe_w_group[layer], moe_b_group[layer],
                         moe_w_expert[layer], moe_b_expert[layer],
                         moe_w_gate[layer], moe_w_up[layer], moe_w_down[layer])
    return rmsnorm(x, final_norm)
```

```cpp
#include <hip/hip_runtime.h>
#include <cstdio>
#include <cstdint>

#ifndef MK_PER_PHASE
#define MK_PER_PHASE 0
#endif
#ifndef RET_NAIVE
#define RET_NAIVE 1
#endif

#define GAS __attribute__((address_space(1)))
#define LAS __attribute__((address_space(3)))
typedef unsigned short bf16_t;
typedef short bf16x8 __attribute__((ext_vector_type(8)));
typedef float f32x4 __attribute__((ext_vector_type(4)));
typedef float f32x2 __attribute__((ext_vector_type(2)));
typedef unsigned u32x4 __attribute__((ext_vector_type(4)));
typedef unsigned u32x2 __attribute__((ext_vector_type(2)));

constexpr int BATCH = 8, SEQ = 4096, DM = 1024, TOK = BATCH * SEQ;
constexpr int NH = 4, DK = 256, DV = 512, QKD = 1024, VD = 2048, NIN = 6144;
constexpr int NE = 32, EPG = 8, DFF = 256;
constexpr int CHUNK = 64, NCHUNK = SEQ / CHUNK;
constexpr float EPS = 1e-6f;
constexpr int NWAVES = 8, NTHREADS = 512;

constexpr size_t MiB = 1u << 20;
constexpr size_t WS_CTL = 0, CTL_ZERO_BYTES = 1 * MiB;
constexpr size_t WS_ROPE = 1 * MiB;
constexpr size_t WS_STATS = 5 * MiB;
constexpr size_t WS_WIN = 6 * MiB;
constexpr size_t WS_WOUT = 18 * MiB;
constexpr size_t WS_WPOOL = 22 * MiB;
constexpr size_t WS_WGU = 23 * MiB;
constexpr size_t WS_WD = 87 * MiB;
constexpr size_t WS_Q = 119 * MiB;
constexpr size_t WS_K = 183 * MiB;
constexpr size_t WS_V = 247 * MiB;
constexpr size_t WS_G = 375 * MiB;
constexpr size_t WS_X1 = 119 * MiB;
constexpr size_t WS_H = 247 * MiB;
constexpr size_t WS_HID = 311 * MiB;
constexpr size_t WS_Y = 349 * MiB;
constexpr size_t WS_POOLED = 349 * MiB;
constexpr size_t WS_SLOT_TOK = 477 * MiB;
constexpr size_t WS_SLOT_W = 481 * MiB;
constexpr size_t WS_END = 503 * MiB;
constexpr int CW_TMO = 0, CW_CODE = 1;
constexpr int CW_BAR = 4096;
constexpr int CW_CNT = 16384;

constexpr int RING_BYTES = 131072;
constexpr int LDS_MOE_TAB = 131072;
constexpr int LDS_RT_LIST = 147456;
constexpr int LDS_RT_CNT = 151552;
constexpr int LDSCTL_OFF = 151808, MISC_OFF = LDSCTL_OFF + 64;
constexpr int LDS_BYTES = 155648;

#define LDS_WAIT() asm volatile("s_waitcnt lgkmcnt(0)" ::: "memory")
#define VM_WAIT() asm volatile("s_waitcnt vmcnt(0)" ::: "memory")
#define RLX_AGENT __ATOMIC_RELAXED, __HIP_MEMORY_SCOPE_AGENT

__device__ __forceinline__ unsigned cvt_pk_bf16(float lo, float hi) { unsigned r; asm volatile("v_cvt_pk_bf16_f32 %0, %1, %2" : "=v"(r) : "v"(lo), "v"(hi)); return r; }
__device__ __forceinline__ float bf2f(unsigned short u) { return __uint_as_float(((unsigned)u) << 16); }
__device__ __forceinline__ float bflo(unsigned u) { return __uint_as_float(u << 16); }
__device__ __forceinline__ float bfhi(unsigned u) { return __uint_as_float(u & 0xffff0000u); }
__device__ __forceinline__ float wave_sum(float v) {
#pragma unroll
    for (int o = 1; o < 64; o <<= 1) v += __shfl_xor(v, o);
    return v;
}
__device__ __forceinline__ float silu_f(float x) { return x / (1.0f + __expf(-x)); }

namespace pg8 {
constexpr int BM = 256, BK = 64, HALF = 128, HTB = HALF * BK * 2, STAGE_BYTES = 8 * HTB, NXCD = 8, WGM = 8;
__host__ __device__ __forceinline__ int lds_byte(int r, int c) { const int st = (r >> 4) * 2 + (c >> 5), rr = r & 15, cc = c & 31, ob = rr * 64 + cc * 2; return st * 1024 + (ob ^ (((ob >> 9) & 1) << 5)); }
__host__ __device__ __forceinline__ void stage_rc(int b, int& R, int& C) { const int st = b / 1024, sb = b % 1024, swz = sb ^ (((sb >> 9) & 1) << 5); R = (st >> 1) * 16 + swz / 64; C = (st & 1) * 32 + (swz % 64) / 2; }
__host__ __device__ __forceinline__ int perm32(int rho) { const int n = rho >> 4, i = rho & 15; return 8 * (i >> 2) + 4 * n + (i & 3); }

struct Unit { int pm, pn, e, r; };

struct DenseSched {
    static constexpr bool GATHER = false;
    const bf16_t* A; const bf16_t* Bt; int lda, ldb, a_col_stride;
    int nM, nN, nwg, G, c;
    __device__ void init(const bf16_t* A_, const bf16_t* Bt_, int lda_, int ldb_, int acs, int M, int N, int G_, int c_) {
        A = A_; Bt = Bt_; lda = lda_; ldb = ldb_; a_col_stride = acs; nM = M / BM; nN = N / BM; nwg = nM * nN; G = G_; c = c_; }
    __device__ bool next(int i, Unit& u) const {
        const long L = (long)i * G + c; if (L >= nwg) return false;
        int wgid = (int)L; { const int q = nwg / NXCD, r = nwg % NXCD, xcd = wgid % NXCD, off = wgid / NXCD; wgid = (xcd < r ? xcd * (q + 1) : r * (q + 1) + (xcd - r) * q) + off; }
        const int nig = WGM * nN, gid = wgid / nig, fm = gid * WGM, gsz = (nM - fm) < WGM ? (nM - fm) : WGM;
        u.pm = fm + ((wgid % nig) % gsz); u.pn = (wgid % nig) / gsz; u.e = 0; u.r = 0; return true;
    }
    __device__ __forceinline__ const char* a_base(const Unit& u) const { return (const char*)(A + (size_t)u.pm * BM * lda + (size_t)u.pn * a_col_stride); }
    __device__ __forceinline__ const char* b_base(const Unit& u) const { return (const char*)(Bt + (size_t)u.pn * BM * ldb); }
    __device__ __forceinline__ unsigned a_row_off(const Unit&, int) const { return 0u; }
};

struct MoeTab { const LAS int* cnt; const LAS int* tstart; };
__device__ __forceinline__ bool moe_unit(const MoeTab& T, int L, int NT, Unit& u) {
    const int total = T.tstart[32];
    if (L >= total * NT) return false;
    const int tile = L / NT; u.pn = L - tile * NT; u.pm = tile;
    int e = 0;
#pragma unroll 1
    for (int j = 1; j < 32; ++j) if (T.tstart[j] <= tile) e = j;
    u.e = e; u.r = tile - T.tstart[e]; return true;
}
struct MoeGuSched {
    static constexpr bool GATHER = true;
    const bf16_t* H; const bf16_t* W; const int* slot_tok; MoeTab T; int L;
    int lda, ldb;
    __device__ bool next(int i, Unit& u) const { if (i != 0) return false; return moe_unit(T, L, 2, u); }
    __device__ __forceinline__ const char* a_base(const Unit&) const { return (const char*)H; }
    __device__ __forceinline__ const char* b_base(const Unit& u) const { return (const char*)(W + ((size_t)u.e * 512 + (size_t)u.pn * 256) * 1024); }
    __device__ __forceinline__ unsigned a_row_off(const Unit& u, int row) const {
        const int slot = u.r * 256 + row; int tok = 0;
        if (slot < T.cnt[u.e]) tok = slot_tok[(size_t)u.e * TOK + slot] >> 1;
        return (unsigned)tok * (unsigned)(DM * 2);
    }
};
struct MoeDownSched {
    static constexpr bool GATHER = false;
    const bf16_t* HID; const bf16_t* W; MoeTab T; int G, c;
    int lda, ldb;
    __device__ bool next(int i, Unit& u) const { return moe_unit(T, i * G + c, 4, u); }
    __device__ __forceinline__ const char* a_base(const Unit& u) const { return (const char*)(HID + (size_t)u.pm * 256 * DFF); }
    __device__ __forceinline__ const char* b_base(const Unit& u) const { return (const char*)(W + ((size_t)u.e * 1024 + (size_t)u.pn * 256) * DFF); }
    __device__ __forceinline__ unsigned a_row_off(const Unit&, int) const { return 0u; }
};


struct EpiQKVG {
    static constexpr bool PERM = true;
    bf16_t *q, *k, *v, *g; const float* rope;
    __device__ __forceinline__ void operator()(const f32x4 (&acc)[2][2][4][2], const Unit& u, int wr, int wc, int fr_in, int fq_in) const {
        int fr = fr_in, fq = fq_in; asm volatile("" : "+v"(fr), "+v"(fq));
        const int pn = u.pn, row0 = u.pm * BM + wr * 64 + fr, cl = wc * 32 + 8 * fq;
        if (pn < 8) {
            bf16_t* dst = (pn < 4 ? q : k) + (size_t)(pn & 3) * 256 + cl;
            const float sc = pn < 4 ? 1.0f : 0.0625f;
#pragma unroll
            for (int ai = 0; ai < 2; ++ai)
#pragma unroll
                for (int m = 0; m < 4; ++m) {
                    const int row = row0 + ai * HALF + m * 16, pos = row & (SEQ - 1);
                    const f32x4* tp = (const f32x4*)(rope + ((size_t)pos * 128 + cl) * 2);
                    const f32x4 t0 = tp[0], t1 = tp[1], t2 = tp[2], t3 = tp[3];
                    const f32x4 a0 = acc[ai][0][m][0], a1 = acc[ai][0][m][1], b0 = acc[ai][1][m][0], b1 = acc[ai][1][m][1];
                    float o1[8], o2[8];
                    o1[0] = a0[0] * t0[0] - b0[0] * t0[1]; o2[0] = a0[0] * t0[1] + b0[0] * t0[0];
                    o1[1] = a0[1] * t0[2] - b0[1] * t0[3]; o2[1] = a0[1] * t0[3] + b0[1] * t0[2];
                    o1[2] = a0[2] * t1[0] - b0[2] * t1[1]; o2[2] = a0[2] * t1[1] + b0[2] * t1[0];
                    o1[3] = a0[3] * t1[2] - b0[3] * t1[3]; o2[3] = a0[3] * t1[3] + b0[3] * t1[2];
                    o1[4] = a1[0] * t2[0] - b1[0] * t2[1]; o2[4] = a1[0] * t2[1] + b1[0] * t2[0];
                    o1[5] = a1[1] * t2[2] - b1[1] * t2[3]; o2[5] = a1[1] * t2[3] + b1[1] * t2[2];
                    o1[6] = a1[2] * t3[0] - b1[2] * t3[1]; o2[6] = a1[2] * t3[1] + b1[2] * t3[0];
                    o1[7] = a1[3] * t3[2] - b1[3] * t3[3]; o2[7] = a1[3] * t3[3] + b1[3] * t3[2];
                    u32x4 w1, w2;
                    w1.x = cvt_pk_bf16(o1[0] * sc, o1[1] * sc); w1.y = cvt_pk_bf16(o1[2] * sc, o1[3] * sc); w1.z = cvt_pk_bf16(o1[4] * sc, o1[5] * sc); w1.w = cvt_pk_bf16(o1[6] * sc, o1[7] * sc);
                    w2.x = cvt_pk_bf16(o2[0] * sc, o2[1] * sc); w2.y = cvt_pk_bf16(o2[2] * sc, o2[3] * sc); w2.z = cvt_pk_bf16(o2[4] * sc, o2[5] * sc); w2.w = cvt_pk_bf16(o2[6] * sc, o2[7] * sc);
                    bf16_t* rp = dst + (size_t)row * QKD;
                    *(u32x4*)(rp) = w1; *(u32x4*)(rp + HALF) = w2;
                }
        } else {
            bf16_t* dst = (pn < 16 ? v + (size_t)(pn - 8) * 256 : g + (size_t)(pn - 16) * 256) + cl;
#pragma unroll
            for (int ai = 0; ai < 2; ++ai)
#pragma unroll
                for (int m = 0; m < 4; ++m) {
                    bf16_t* rp = dst + (size_t)(row0 + ai * HALF + m * 16) * VD;
#pragma unroll
                    for (int bj = 0; bj < 2; ++bj) { const f32x4 v0 = acc[ai][bj][m][0], v1 = acc[ai][bj][m][1];
                        u32x4 w; w.x = cvt_pk_bf16(v0[0], v0[1]); w.y = cvt_pk_bf16(v0[2], v0[3]); w.z = cvt_pk_bf16(v1[0], v1[1]); w.w = cvt_pk_bf16(v1[2], v1[3]);
                        *(u32x4*)(rp + bj * HALF) = w; }
                }
        }
    }
};
struct EpiResid {
    static constexpr bool PERM = false;
    const float* base; float* out; const float* scale;
    __device__ __forceinline__ void operator()(const f32x4 (&acc)[2][2][4][2], const Unit& u, int wr, int wc, int fr_in, int fq_in) const {
        int fr = fr_in, fq = fq_in; asm volatile("" : "+v"(fr), "+v"(fq));
        const int col0 = u.pn * BM + wc * 32 + 4 * fq;
        f32x4 sv[2][2];
#pragma unroll
        for (int bj = 0; bj < 2; ++bj)
#pragma unroll
            for (int n = 0; n < 2; ++n) sv[bj][n] = scale ? *(const f32x4*)(scale + col0 + bj * HALF + n * 16) : (f32x4){1.f, 1.f, 1.f, 1.f};
#pragma unroll
        for (int ai = 0; ai < 2; ++ai)
#pragma unroll
            for (int m = 0; m < 4; ++m) { const size_t off = (size_t)(u.pm * BM + ai * HALF + wr * 64 + m * 16 + fr) * DM + col0;
#pragma unroll
                for (int bj = 0; bj < 2; ++bj)
#pragma unroll
                    for (int n = 0; n < 2; ++n) { const f32x4 bs = *(const f32x4*)(base + off + bj * HALF + n * 16);
                        *(f32x4*)(out + off + bj * HALF + n * 16) = bs + acc[ai][bj][m][n] * sv[bj][n]; } }
    }
};
struct EpiGateUp {
    static constexpr bool PERM = true;
    bf16_t* hid;
    __device__ __forceinline__ void operator()(const f32x4 (&acc)[2][2][4][2], const Unit& u, int wr, int wc, int fr_in, int fq_in) const {
        int fr = fr_in, fq = fq_in; asm volatile("" : "+v"(fr), "+v"(fq));
        bf16_t* dst = hid + (size_t)u.pm * 256 * DFF + u.pn * 128 + wc * 32 + 8 * fq;
#pragma unroll
        for (int ai = 0; ai < 2; ++ai)
#pragma unroll
            for (int m = 0; m < 4; ++m) {
                const f32x4 g0 = acc[ai][0][m][0], g1 = acc[ai][0][m][1], u0 = acc[ai][1][m][0], u1 = acc[ai][1][m][1];
                u32x4 w;
                w.x = cvt_pk_bf16(silu_f(g0[0]) * u0[0], silu_f(g0[1]) * u0[1]); w.y = cvt_pk_bf16(silu_f(g0[2]) * u0[2], silu_f(g0[3]) * u0[3]);
                w.z = cvt_pk_bf16(silu_f(g1[0]) * u1[0], silu_f(g1[1]) * u1[1]); w.w = cvt_pk_bf16(silu_f(g1[2]) * u1[2], silu_f(g1[3]) * u1[3]);
                *(u32x4*)(dst + (size_t)(ai * HALF + wr * 64 + m * 16 + fr) * DFF) = w;
            }
    }
};
struct EpiDown {
    static constexpr bool PERM = true;
    bf16_t* y; const int* slot_tok; const float* slot_w; MoeTab T;
    __device__ __forceinline__ void operator()(const f32x4 (&acc)[2][2][4][2], const Unit& u, int wr, int wc, int fr_in, int fq_in) const {
        int fr = fr_in, fq = fq_in; asm volatile("" : "+v"(fr), "+v"(fq));
        const int cnt = T.cnt[u.e]; const int cl = u.pn * BM + wc * 32 + 8 * fq;
#pragma unroll
        for (int ai = 0; ai < 2; ++ai)
#pragma unroll
            for (int m = 0; m < 4; ++m) {
                const int slot = u.r * 256 + ai * HALF + wr * 64 + m * 16 + fr;
                if (slot < cnt) {
                    const int p = slot_tok[(size_t)u.e * TOK + slot]; const float w = slot_w[(size_t)u.e * TOK + slot];
                    bf16_t* rp = y + ((size_t)(p & 1) * TOK + (size_t)(p >> 1)) * DM + cl;
#pragma unroll
                    for (int bj = 0; bj < 2; ++bj) { const f32x4 v0 = acc[ai][bj][m][0] * w, v1 = acc[ai][bj][m][1] * w;
                        u32x4 o; o.x = cvt_pk_bf16(v0[0], v0[1]); o.y = cvt_pk_bf16(v0[2], v0[3]); o.z = cvt_pk_bf16(v1[0], v1[1]); o.w = cvt_pk_bf16(v1[2], v1[3]);
                        *(u32x4*)(rp + bj * HALF) = o; }
                }
            }
    }
};

template <class Epi, class Sched, bool ALIGN_EPI>
__device__ __forceinline__ void gemm_phase(LAS unsigned char* lds, const int K, const Sched& S, const Epi& E) {
    int tid = threadIdx.x; asm volatile("" : "+v"(tid));
    const int wid = __builtin_amdgcn_readfirstlane(tid >> 6), lane = tid & 63, wr = wid >> 2, wc = wid & 3, fr = lane & 15, fq = lane >> 4;
    const int nt = K / BK;
    const unsigned lda_b = (unsigned)S.lda * 2u, ldb_b = (unsigned)S.ldb * 2u;
    int Rs[2], Cs[2];
    unsigned voffA[2][2], voffB[2];
#pragma unroll
    for (int i = 0; i < 2; ++i) { stage_rc(tid * 16 + i * 8192, Rs[i], Cs[i]); const int Rb = Epi::PERM ? ((Rs[i] & ~31) + perm32(Rs[i] & 31)) : Rs[i];
        voffB[i] = (unsigned)Rb * ldb_b + (unsigned)Cs[i] * 2u;
        voffA[0][i] = (unsigned)Rs[i] * lda_b + (unsigned)Cs[i] * 2u; voffA[1][i] = voffA[0][i]; }
    const size_t kstep = (size_t)(BK * 2);
    const size_t hstepA = Sched::GATHER ? 0 : (size_t)HALF * lda_b;
    const size_t hstepB = (size_t)HALF * ldb_b;
    const unsigned ldsw = (unsigned)wid * 1024u;
    const int aoff = lds_byte(wr * 64 + fr, fq * 8), boff = lds_byte(wc * 32 + fr, fq * 8);
#define PG8_SA(b, h) (((b) * 2 + (h)) * HTB)
#define PG8_SB(b, h) ((4 + (b) * 2 + (h)) * HTB)
#define PG8_STAGEA(bufoff, gbase, h) do { _Pragma("unroll") for (int _i = 0; _i < 2; ++_i) \
        __builtin_amdgcn_global_load_lds((const unsigned*)((const char*)(gbase) + voffA[h][_i]), (LAS unsigned*)(lds + (bufoff) + ldsw + _i * 8192), 16, 0, 0); } while (0)
#define PG8_STAGEB(bufoff, gbase) do { _Pragma("unroll") for (int _i = 0; _i < 2; ++_i) \
        __builtin_amdgcn_global_load_lds((const unsigned*)((const char*)(gbase) + voffB[_i]), (LAS unsigned*)(lds + (bufoff) + ldsw + _i * 8192), 16, 0, 0); } while (0)
#define PG8_LDA(dst, b, h) do { _Pragma("unroll") for (int m = 0; m < 4; ++m) _Pragma("unroll") for (int k = 0; k < 2; ++k) dst[m][k] = *(const LAS bf16x8*)(lds + PG8_SA(b, h) + aoff + m * 2048 + k * 1024); } while (0)
#define PG8_LDB(dst, b, h) do { _Pragma("unroll") for (int n = 0; n < 2; ++n) _Pragma("unroll") for (int k = 0; k < 2; ++k) dst[n][k] = *(const LAS bf16x8*)(lds + PG8_SB(b, h) + boff + n * 2048 + k * 1024); } while (0)
#define PG8_MMA(ai, bj, At, Bt) do { __builtin_amdgcn_s_setprio(1); _Pragma("unroll") for (int m = 0; m < 4; ++m) _Pragma("unroll") for (int n = 0; n < 2; ++n) _Pragma("unroll") for (int k = 0; k < 2; ++k) \
        acc[ai][bj][m][n] = __builtin_amdgcn_mfma_f32_16x16x32_bf16(Bt[n][k], At[m][k], acc[ai][bj][m][n], 0, 0, 0); __builtin_amdgcn_s_setprio(0); } while (0)
#define PG8_WAIT_V(n) asm volatile("s_waitcnt vmcnt(" #n ")" ::: "memory")
#define PG8_WAIT_L(n) asm volatile("s_waitcnt lgkmcnt(" #n ")" ::: "memory")
#define PG8_BAR __builtin_amdgcn_s_barrier()
#define PG8_SCHED __builtin_amdgcn_sched_barrier(0)
    Unit cur, nxt; int ui = 0;
    if (!S.next(0, cur)) return;
    if constexpr (Sched::GATHER) {
#pragma unroll
        for (int h = 0; h < 2; ++h)
#pragma unroll
            for (int i = 0; i < 2; ++i) voffA[h][i] = S.a_row_off(cur, h * HALF + Rs[i]) + (unsigned)Cs[i] * 2u;
    }
    f32x4 acc[2][2][4][2];
#pragma unroll
    for (int a = 0; a < 2; ++a)
#pragma unroll
        for (int b = 0; b < 2; ++b)
#pragma unroll
            for (int m = 0; m < 4; ++m)
#pragma unroll
                for (int n = 0; n < 2; ++n) acc[a][b][m][n] = (f32x4){0.f, 0.f, 0.f, 0.f};
    bf16x8 At[4][2], B0[2][2], B1[2][2];
    const char* cA = S.a_base(cur); const char* cB = S.b_base(cur);
    PG8_STAGEB(PG8_SB(0, 0), cB); PG8_STAGEB(PG8_SB(0, 1), cB + hstepB); PG8_STAGEA(PG8_SA(0, 0), cA, 0); PG8_STAGEA(PG8_SA(0, 1), cA + hstepA, 1);
    if (wr == 1) PG8_BAR;
    PG8_WAIT_V(2); PG8_BAR;
    PG8_STAGEB(PG8_SB(1, 0), cB + kstep); PG8_STAGEA(PG8_SA(1, 0), cA + kstep, 0); PG8_STAGEB(PG8_SB(1, 1), cB + hstepB + kstep);
    PG8_WAIT_V(6); PG8_BAR;
    for (;;) {
        const bool has_next = Sched::GATHER ? false : S.next(ui + 1, nxt);
        const char* nA = has_next ? S.a_base(nxt) : cA; const char* nB = has_next ? S.b_base(nxt) : cB;
        for (int t = 0; t < nt; t += 2) {
            const bool last = (t == nt - 2);
            const char* a1 = cA + (size_t)(t + 1) * kstep;
            const char* a2 = last ? nA : cA + (size_t)(t + 2) * kstep; const char* b2 = last ? nB : cB + (size_t)(t + 2) * kstep;
            const char* a3 = a2 + kstep; const char* b3 = b2 + kstep;
            PG8_LDB(B0, 0, 0); PG8_LDB(B1, 0, 1); PG8_SCHED; PG8_LDA(At, 0, 0); PG8_STAGEA(PG8_SA(1, 1), a1 + hstepA, 1);
            PG8_WAIT_V(8); PG8_WAIT_L(0); PG8_BAR; PG8_MMA(0, 0, At, B0); PG8_MMA(0, 1, At, B1); PG8_BAR; PG8_SCHED;
            PG8_LDA(At, 0, 1); PG8_STAGEB(PG8_SB(0, 0), b2); PG8_STAGEB(PG8_SB(0, 1), b2 + hstepB); PG8_STAGEA(PG8_SA(0, 0), a2, 0);
            PG8_WAIT_V(8); PG8_WAIT_L(0); PG8_BAR; PG8_MMA(1, 0, At, B0); PG8_MMA(1, 1, At, B1); PG8_BAR; PG8_SCHED;
            PG8_LDB(B0, 1, 0); PG8_LDB(B1, 1, 1); PG8_SCHED; PG8_LDA(At, 1, 0); PG8_STAGEA(PG8_SA(0, 1), a2 + hstepA, 1);
            PG8_WAIT_V(8); PG8_WAIT_L(0); PG8_BAR; PG8_MMA(0, 0, At, B0); PG8_MMA(0, 1, At, B1); PG8_BAR; PG8_SCHED;
            PG8_LDA(At, 1, 1); PG8_STAGEB(PG8_SB(1, 0), b3); PG8_STAGEB(PG8_SB(1, 1), b3 + hstepB); PG8_STAGEA(PG8_SA(1, 0), a3, 0);
            PG8_WAIT_V(8); PG8_WAIT_L(0); PG8_BAR; PG8_MMA(1, 0, At, B0); PG8_MMA(1, 1, At, B1); PG8_BAR; PG8_SCHED;
        }
        if constexpr (ALIGN_EPI) { if (wr == 0) PG8_BAR; }
        E(acc, cur, wr, wc, fr, fq);
        if (!has_next) break;
#pragma unroll
        for (int a = 0; a < 2; ++a)
#pragma unroll
            for (int b = 0; b < 2; ++b)
#pragma unroll
                for (int m = 0; m < 4; ++m)
#pragma unroll
                    for (int n = 0; n < 2; ++n) acc[a][b][m][n] = (f32x4){0.f, 0.f, 0.f, 0.f};
        cur = nxt; cA = nA; cB = nB; ++ui;
        if constexpr (ALIGN_EPI) { if (wr == 1) PG8_BAR; }
    }
    PG8_WAIT_V(0);
    if constexpr (!ALIGN_EPI) { if (wr == 0) PG8_BAR; }
    PG8_BAR;
#undef PG8_SA
#undef PG8_SB
#undef PG8_STAGEA
#undef PG8_STAGEB
#undef PG8_LDA
#undef PG8_LDB
#undef PG8_MMA
#undef PG8_WAIT_V
#undef PG8_WAIT_L
#undef PG8_BAR
#undef PG8_SCHED
}
}

#define XB_TMO      128
#define XB_XCNT(j)  (256  + 64 * (j))
#define XB_XSUB(j)  (1280 + 64 * (j))
#define XB_XGEN(j)  (2304 + 64 * (j))
#define XB_TOP      3328
#define XB_TOPGEN   3392
#define XCD_BAR_WORDS 3456
#define XB_SPIN_CAP (1u << 18)
__device__ __forceinline__ unsigned xb_ld(unsigned* p)              { return __hip_atomic_load(p, __ATOMIC_RELAXED, __HIP_MEMORY_SCOPE_AGENT); }
__device__ __forceinline__ unsigned xb_add(unsigned* p, unsigned v) { return __hip_atomic_fetch_add(p, v, __ATOMIC_RELAXED, __HIP_MEMORY_SCOPE_AGENT); }
__device__ __forceinline__ unsigned xb_xcc_id() { return (unsigned)__builtin_amdgcn_s_getreg((3 << 11) | 20) & 0xFu; }
#define XB_SPIN(cond, bar) do { unsigned _sp = 0; while (cond) { __builtin_amdgcn_s_sleep(1); \
    if ((++_sp & 255u) == 0u) { if (xb_ld(&(bar)[XB_TMO])) break; if (_sp > XB_SPIN_CAP) { atomicAdd(&(bar)[XB_TMO], 1u); break; } } } } while (0)
struct XcdBarrier { unsigned* bar; unsigned x; volatile LAS unsigned* st; };
__device__ __forceinline__ XcdBarrier xcd_barrier_post(unsigned* bar, volatile LAS unsigned* st) {
    XcdBarrier b; b.bar = bar; b.x = xb_xcc_id(); b.st = st;
    if (threadIdx.x == 0) (void)xb_add(&bar[XB_XCNT(b.x)], 1u);
    return b;
}
__device__ __forceinline__ void xcd_barrier_complete(unsigned* bar, unsigned x, unsigned& nloc, unsigned& nx) {
    const unsigned G = gridDim.x * gridDim.y * gridDim.z;
    unsigned sum, cnt, mine, sp = 0u;
    for (;;) {
        sum = 0u; cnt = 0u; mine = 0u;
#pragma unroll
        for (unsigned j = 0; j < 16; ++j) { const unsigned c = xb_ld(&bar[XB_XCNT(j)]); sum += c; cnt += (c > 0u) ? 1u : 0u; mine = (j == x) ? c : mine; }
        if (sum == G) break;
        __builtin_amdgcn_s_sleep(1);
        if ((++sp & 255u) == 0u) { if (xb_ld(&bar[XB_TMO])) break; if (sp > XB_SPIN_CAP) { atomicAdd(&bar[XB_TMO], 1u); break; } }
    }
    nloc = mine > 0u ? mine : 1u; nx = cnt > 0u ? cnt : 1u;
}
__device__ __forceinline__ void xcd_barrier(const XcdBarrier& b) {
    asm volatile("s_waitcnt vmcnt(0)" ::: "memory");
    __syncthreads();
    if (threadIdx.x == 0) {
        unsigned* bar = b.bar;
        __builtin_amdgcn_s_waitcnt(0);
        unsigned nloc = b.st[0], nx = b.st[1];
        if (nloc == 0u) { xcd_barrier_complete(bar, b.x, nloc, nx); b.st[0] = nloc; b.st[1] = nx; }
        const unsigned old = xb_add(&bar[XB_XSUB(b.x)], 1u);
        const unsigned gen = old / nloc;
        if (old + 1u == (gen + 1u) * nloc) {
            __builtin_amdgcn_fence(__ATOMIC_RELEASE, "agent");
            asm volatile("s_waitcnt vmcnt(0)" ::: "memory");
            const unsigned og = xb_add(&bar[XB_TOP], 1u);
            const unsigned tg = og / nx;
            if (og + 1u == (tg + 1u) * nx) xb_add(&bar[XB_TOPGEN], 1u);
            else XB_SPIN(xb_ld(&bar[XB_TOPGEN]) == tg, bar);
            __builtin_amdgcn_fence(__ATOMIC_ACQUIRE, "agent");
            xb_add(&bar[XB_XGEN(b.x)], 1u);
            asm volatile("s_waitcnt vmcnt(0)" ::: "memory");
        } else {
            XB_SPIN(xb_ld(&bar[XB_XGEN(b.x)]) == gen, bar);
            __builtin_amdgcn_fence(__ATOMIC_ACQUIRE, "agent");
            asm volatile("s_waitcnt vmcnt(0)" ::: "memory");
        }
    }
    __syncthreads();
}

struct Frame {
    LAS unsigned char* lds;
    volatile LAS unsigned* MISC;
    unsigned* ctl;
    int wave, vcu, G;
    __device__ __forceinline__ int ftid() const { int t = threadIdx.x; asm volatile("" : "+v"(t)); return t; }
    unsigned char* ws; float* out;
    const float *x, *norm_mix, *norm_ffn, *ret_w_in, *ret_w_out, *pool_w, *pool_scale, *moe_w_group, *moe_b_group, *moe_w_expert, *moe_b_expert, *moe_w_gate, *moe_w_up, *moe_w_down, *final_norm;
};

__device__ __forceinline__ void p0_transpose_item(const float* W, int K, int N, bf16_t* WT, int k0, int n0, int dst_row0, LAS float* scr, int lane) {
#pragma unroll 8
    for (int i = 0; i < 32; ++i) { const int kk = 2 * i + (lane >> 5); scr[kk * 33 + (lane & 31)] = W[(size_t)(k0 + kk) * N + n0 + (lane & 31)]; }
    LDS_WAIT(); asm volatile("" ::: "memory");
    const int c = lane & 7;
#pragma unroll
    for (int j = 0; j < 4; ++j) { const int n = (lane >> 3) + 8 * j; const LAS float* s = scr + (8 * c) * 33 + n;
        u32x4 o; o.x = cvt_pk_bf16(s[0 * 33], s[1 * 33]); o.y = cvt_pk_bf16(s[2 * 33], s[3 * 33]); o.z = cvt_pk_bf16(s[4 * 33], s[5 * 33]); o.w = cvt_pk_bf16(s[6 * 33], s[7 * 33]);
        *(GAS u32x4*)(WT + (size_t)(dst_row0 + n) * K + k0 + 8 * c) = o; }
    LDS_WAIT(); asm volatile("" ::: "memory");
}
__device__ __forceinline__ void rms_row_to_bf16(int lane, const float* xrow, const float* gain, bf16_t* orow) {
    const GAS f32x4* xr = (const GAS f32x4*)xrow + lane;
    const GAS f32x4* gr = (const GAS f32x4*)gain + lane;
    f32x4 v[4]; float s = 0.f;
#pragma unroll
    for (int j = 0; j < 4; ++j) { v[j] = xr[64 * j]; s += (v[j].x * v[j].x + v[j].y * v[j].y) + (v[j].z * v[j].z + v[j].w * v[j].w); }
    const float inv = 1.0f / sqrtf(wave_sum(s) * (1.f / DM) + EPS);
    GAS u32x2* o8 = (GAS u32x2*)orow + lane;
#pragma unroll
    for (int j = 0; j < 4; ++j) { const f32x4 gg = gr[64 * j]; u32x2 w; w.x = cvt_pk_bf16(v[j].x * inv * gg.x, v[j].y * inv * gg.y); w.y = cvt_pk_bf16(v[j].z * inv * gg.z, v[j].w * inv * gg.w); o8[64 * j] = w; }
}

__device__ __forceinline__ void p0_prologue(Frame& F) {
    const int tid0 = F.ftid(), lane0 = tid0 & 63;
    LAS float* scr = (LAS float*)(F.lds + F.wave * 16384);
    const int gw = F.vcu * NWAVES + F.wave, NGW = F.G * NWAVES;
    bf16_t* win_t = (bf16_t*)(F.ws + WS_WIN); bf16_t* wout_t = (bf16_t*)(F.ws + WS_WOUT); bf16_t* wpool_t = (bf16_t*)(F.ws + WS_WPOOL);
    bf16_t* wgu_t = (bf16_t*)(F.ws + WS_WGU); bf16_t* wd_t = (bf16_t*)(F.ws + WS_WD);
    constexpr int I_IN = (DM / 64) * (NIN / 32);
    constexpr int I_OUT = (VD / 64) * (DM / 32);
    constexpr int I_POOL = 4 * (256 / 64) * (256 / 32);
    constexpr int I_GU1 = (DM / 64) * (DFF / 32);
    constexpr int I_GU = 64 * 2 * I_GU1;
    constexpr int I_D1 = (DFF / 64) * (DM / 32);
    constexpr int I_D = 64 * I_D1;
    constexpr int NITEMS = I_IN + I_OUT + I_POOL + I_GU + I_D;
    for (int it = gw; it < NITEMS; it += NGW) {
        int r = it;
        if (r < I_IN) { const int nblk = NIN / 32, kb = r / nblk, nb = r % nblk; p0_transpose_item(F.ret_w_in, DM, NIN, win_t, 64 * kb, 32 * nb, 32 * nb, scr, lane0); continue; } r -= I_IN;
        if (r < I_OUT) { const int nblk = DM / 32, kb = r / nblk, nb = r % nblk; p0_transpose_item(F.ret_w_out, VD, DM, wout_t, 64 * kb, 32 * nb, 32 * nb, scr, lane0); continue; } r -= I_OUT;
        if (r < I_POOL) { const int g = r / 32, q = r % 32, kb = q / 8, nb = q % 8; p0_transpose_item(F.pool_w + (size_t)g * 65536, 256, 256, wpool_t, 64 * kb, 32 * nb, g * 256 + 32 * nb, scr, lane0); continue; } r -= I_POOL;
        if (r < I_GU) { const int le = r / (2 * I_GU1), q = r % (2 * I_GU1), isup = q / I_GU1, q2 = q % I_GU1, kb = q2 / 8, nb = q2 % 8, n0 = 32 * nb;
            const float* W = (isup ? F.moe_w_up : F.moe_w_gate) + (size_t)le * DM * DFF;
            p0_transpose_item(W, DM, DFF, wgu_t + (size_t)le * 512 * DM, 64 * kb, n0, 256 * (n0 >> 7) + 128 * isup + (n0 & 127), scr, lane0); continue; } r -= I_GU;
        { const int le = r / I_D1, q = r % I_D1, kb = q / 32, nb = q % 32;
            p0_transpose_item(F.moe_w_down + (size_t)le * DFF * DM, DFF, DM, wd_t + (size_t)le * DM * DFF, 64 * kb, 32 * nb, 32 * nb, scr, lane0); }
    }
    { float2* tab = (float2*)(F.ws + WS_ROPE);
      for (int idx = (F.vcu * NTHREADS + tid0); idx < SEQ * 128; idx += F.G * NTHREADS) {
          const int pos = idx >> 7, i = idx & 127;
          const double inv = exp2(-(double)i * (1.0 / 128.0) * 13.287712379549449);
          const double ang = (double)pos * inv;
          double fr = ang * 0.15915494309189535; fr -= floor(fr);
          const float rr = (float)(fr * 6.283185307179586);
          float s, c; sincosf(rr, &s, &c);
          tab[idx] = make_float2(c, s);
      } }
    { f32x4* st = (f32x4*)(F.ws + WS_STATS);
      for (int idx = (F.vcu * NTHREADS + tid0); idx < (int)(MiB / 16); idx += F.G * NTHREADS) st[idx] = (f32x4){0.f, 0.f, 0.f, 0.f}; }
    { bf16_t* h0 = (bf16_t*)F.out;
      for (int m = gw; m < TOK; m += NGW) rms_row_to_bf16(lane0, F.x + (size_t)m * DM, F.norm_mix, h0 + (size_t)m * DM); }
}

#if RET_NAIVE
__device__ __forceinline__ void p2_retention_naive(Frame& F) {
    const bf16_t* qb = (const bf16_t*)(F.ws + WS_Q); const bf16_t* kb = (const bf16_t*)(F.ws + WS_K); const bf16_t* vb = (const bf16_t*)(F.ws + WS_V);
    bf16_t* ob = (bf16_t*)F.out; float* stats = (float*)(F.ws + WS_STATS);
    LAS bf16_t* Qs = (LAS bf16_t*)(F.lds);
    LAS bf16_t* Ks = (LAS bf16_t*)(F.lds + 32768);
    LAS bf16_t* Vs = (LAS bf16_t*)(F.lds + 65536);
    LAS float* Ss = (LAS float*)(F.lds + 131072);
    const int tid = F.ftid(); const int lane_n = tid & 63;
    for (int item = F.vcu; item < BATCH * NH * NCHUNK; item += F.G) {
        const int n = (NCHUNK - 1) - (item / (BATCH * NH)); const int bh = item % (BATCH * NH); const int b = bh / NH, h = bh % NH;
        const float lg = logf(1.0f - exp2f(-5.0f - (float)h));
        const size_t tok0 = (size_t)b * SEQ + (size_t)n * CHUNK;
        __syncthreads();
        for (int idx = tid; idx < 64 * 32; idx += NTHREADS) { const int r = idx >> 5, c8 = idx & 31; *(LAS u32x4*)(Qs + r * 256 + c8 * 8) = *(const u32x4*)(qb + (tok0 + r) * QKD + h * 256 + c8 * 8); }
        float acc[64];
#pragma unroll
        for (int q = 0; q < 64; ++q) acc[q] = 0.f;
        for (int m = 0; m <= n; ++m) {
            const size_t ktok0 = (size_t)b * SEQ + (size_t)m * CHUNK;
            __syncthreads();
            for (int idx = tid; idx < 64 * 32; idx += NTHREADS) { const int r = idx >> 5, c8 = idx & 31; *(LAS u32x4*)(Ks + r * 256 + c8 * 8) = *(const u32x4*)(kb + (ktok0 + r) * QKD + h * 256 + c8 * 8); }
            for (int idx = tid; idx < 64 * 64; idx += NTHREADS) { const int r = idx >> 6, c8 = idx & 63; *(LAS u32x4*)(Vs + r * 512 + c8 * 8) = *(const u32x4*)(vb + (ktok0 + r) * VD + h * 512 + c8 * 8); }
            __syncthreads();
            { const int q = tid >> 3, k0 = (tid & 7) * 8;
              float s[8];
#pragma unroll
              for (int kk = 0; kk < 8; ++kk) s[kk] = 0.f;
              for (int d = 0; d < 256; d += 2) {
                  const unsigned qq = *(const LAS unsigned*)(Qs + q * 256 + d); const float q0 = bflo(qq), q1 = bfhi(qq);
#pragma unroll
                  for (int kk = 0; kk < 8; ++kk) { const unsigned kv = *(const LAS unsigned*)(Ks + (k0 + kk) * 256 + d); s[kk] += q0 * bflo(kv) + q1 * bfhi(kv); }
              }
#pragma unroll
              for (int kk = 0; kk < 8; ++kk) { const int kq = k0 + kk; const int dist = (m == n) ? (q > kq ? q - kq : kq - q) : (64 * (n - m) + q - kq);
                  Ss[q * 64 + kq] = s[kk] * __expf(lg * (float)dist); } }
            __syncthreads();
            for (int k = 0; k < 64; ++k) {
                const float vk = bf2f(Vs[k * 512 + tid]);
#pragma unroll
                for (int q = 0; q < 64; ++q) acc[q] += Ss[q * 64 + k] * vk;
            }
        }
#pragma unroll
        for (int q = 0; q < 64; ++q) {
            const float a = acc[q];
            ob[(tok0 + q) * VD + h * 512 + tid] = (bf16_t)(cvt_pk_bf16(a, 0.f) & 0xffffu);
            const float s1 = wave_sum(a), s2 = wave_sum(a * a);
            if (lane_n == 0) { atomicAdd(stats + ((tok0 + q) * NH + h) * 2, s1); atomicAdd(stats + ((tok0 + q) * NH + h) * 2 + 1, s2); }
        }
    }
}
#endif

__device__ __forceinline__ void p3_gating(Frame& F) {
    bf16_t* ob = (bf16_t*)F.out; const bf16_t* gb = (const bf16_t*)(F.ws + WS_G); const float* stats = (const float*)(F.ws + WS_STATS);
    const int lane3 = F.ftid() & 63;
    const int gw = F.vcu * NWAVES + F.wave, NGW = F.G * NWAVES;
    for (int m = gw; m < TOK; m += NGW) {
#pragma unroll
        for (int j = 0; j < 4; ++j) {
            const float s1 = stats[((size_t)m * NH + j) * 2], s2 = stats[((size_t)m * NH + j) * 2 + 1];
            const float mu = s1 * (1.f / DV); const float var = fmaxf(s2 * (1.f / DV) - mu * mu, 0.f); const float rstd = 1.0f / sqrtf(var + EPS);
            u32x4* op = (u32x4*)(ob + (size_t)m * VD + j * 512) + lane3; const u32x4 ov = *op; const u32x4 gv = *((const u32x4*)(gb + (size_t)m * VD + j * 512) + lane3);
            u32x4 r;
            r.x = cvt_pk_bf16(silu_f(bflo(gv.x)) * (bflo(ov.x) - mu) * rstd, silu_f(bfhi(gv.x)) * (bfhi(ov.x) - mu) * rstd);
            r.y = cvt_pk_bf16(silu_f(bflo(gv.y)) * (bflo(ov.y) - mu) * rstd, silu_f(bfhi(gv.y)) * (bfhi(ov.y) - mu) * rstd);
            r.z = cvt_pk_bf16(silu_f(bflo(gv.z)) * (bflo(ov.z) - mu) * rstd, silu_f(bfhi(gv.z)) * (bfhi(ov.z) - mu) * rstd);
            r.w = cvt_pk_bf16(silu_f(bflo(gv.w)) * (bflo(ov.w) - mu) * rstd, silu_f(bfhi(gv.w)) * (bfhi(ov.w) - mu) * rstd);
            *op = r;
        }
    }
}

__device__ __forceinline__ void p_router(Frame& F, const float* xs, const float* gain, const float* wg, const float* bg, const float* we, const float* be, int layer) {
    LAS f32x4* wgL = (LAS f32x4*)(F.lds);
    LAS f32x4* weL = (LAS f32x4*)(F.lds + 16384);
    LAS int* list = (LAS int*)(F.lds + LDS_RT_LIST);
    LAS int* lcnt = (LAS int*)(F.lds + LDS_RT_CNT);
    bf16_t* hb = (bf16_t*)(F.ws + WS_H); int* slot_tok = (int*)(F.ws + WS_SLOT_TOK); float* slot_w = (float*)(F.ws + WS_SLOT_W);
    unsigned* cntg = F.ctl + CW_CNT + layer * 32 * 64;
    const int tid = F.ftid(); const int lane = tid & 63;
    __syncthreads();
    for (int k = tid; k < DM; k += NTHREADS) { const int sl = ((k >> 8) * 4 + (k & 3)) * 64 + ((k >> 2) & 63);
        wgL[sl] = *(const f32x4*)(wg + (size_t)k * 4);
#pragma unroll
        for (int g = 0; g < 4; ++g) { weL[(g * 2 + 0) * 1024 + sl] = *(const f32x4*)(we + (size_t)k * 32 + g * 8); weL[(g * 2 + 1) * 1024 + sl] = *(const f32x4*)(we + (size_t)k * 32 + g * 8 + 4); } }
    if (tid < 64) lcnt[tid] = 0;
    __syncthreads();
    const float bg0 = bg[0], bg1 = bg[1], bg2 = bg[2], bg3 = bg[3];
    const int rows_per_blk = TOK / F.G;
    const int row_base = F.vcu * rows_per_blk;
    for (int rr = F.wave; rr < rows_per_blk; rr += NWAVES) {
        const int m = row_base + rr;
        const GAS f32x4* xr = (const GAS f32x4*)(xs + (size_t)m * DM) + lane; const GAS f32x4* gr = (const GAS f32x4*)gain + lane;
        f32x4 v[4]; float s = 0.f;
#pragma unroll
        for (int j = 0; j < 4; ++j) { v[j] = xr[64 * j]; s += (v[j].x * v[j].x + v[j].y * v[j].y) + (v[j].z * v[j].z + v[j].w * v[j].w); }
        const float inv = 1.0f / sqrtf(wave_sum(s) * (1.f / DM) + EPS);
        GAS u32x2* o8 = (GAS u32x2*)(hb + (size_t)m * DM) + lane;
        f32x4 gl = (f32x4){0.f, 0.f, 0.f, 0.f};
#pragma unroll
        for (int j = 0; j < 4; ++j) { const f32x4 gg = gr[64 * j]; v[j].x = v[j].x * inv * gg.x; v[j].y = v[j].y * inv * gg.y; v[j].z = v[j].z * inv * gg.z; v[j].w = v[j].w * inv * gg.w;
            u32x2 w; w.x = cvt_pk_bf16(v[j].x, v[j].y); w.y = cvt_pk_bf16(v[j].z, v[j].w); o8[64 * j] = w;
            gl += wgL[(j * 4 + 0) * 64 + lane] * v[j].x; gl += wgL[(j * 4 + 1) * 64 + lane] * v[j].y; gl += wgL[(j * 4 + 2) * 64 + lane] * v[j].z; gl += wgL[(j * 4 + 3) * 64 + lane] * v[j].w; }
        float l0 = wave_sum(gl.x) + bg0, l1 = wave_sum(gl.y) + bg1, l2 = wave_sum(gl.z) + bg2, l3 = wave_sum(gl.w) + bg3;
        int grp = 0; float lm = l0;
        if (l1 > lm) { lm = l1; grp = 1; } if (l2 > lm) { lm = l2; grp = 2; } if (l3 > lm) { lm = l3; grp = 3; }
        const float ggate = 1.0f / (expf(l0 - lm) + expf(l1 - lm) + expf(l2 - lm) + expf(l3 - lm));
        f32x4 ea = (f32x4){0.f, 0.f, 0.f, 0.f}, eb = (f32x4){0.f, 0.f, 0.f, 0.f};
        const LAS f32x4* wa = weL + (grp * 2 + 0) * 1024; const LAS f32x4* wb = weL + (grp * 2 + 1) * 1024;
#pragma unroll
        for (int j = 0; j < 4; ++j) {
            ea += wa[(j * 4 + 0) * 64 + lane] * v[j].x; eb += wb[(j * 4 + 0) * 64 + lane] * v[j].x;
            ea += wa[(j * 4 + 1) * 64 + lane] * v[j].y; eb += wb[(j * 4 + 1) * 64 + lane] * v[j].y;
            ea += wa[(j * 4 + 2) * 64 + lane] * v[j].z; eb += wb[(j * 4 + 2) * 64 + lane] * v[j].z;
            ea += wa[(j * 4 + 3) * 64 + lane] * v[j].w; eb += wb[(j * 4 + 3) * 64 + lane] * v[j].w; }
        float el[8];
        el[0] = wave_sum(ea.x) + be[grp * 8 + 0]; el[1] = wave_sum(ea.y) + be[grp * 8 + 1]; el[2] = wave_sum(ea.z) + be[grp * 8 + 2]; el[3] = wave_sum(ea.w) + be[grp * 8 + 3];
        el[4] = wave_sum(eb.x) + be[grp * 8 + 4]; el[5] = wave_sum(eb.y) + be[grp * 8 + 5]; el[6] = wave_sum(eb.z) + be[grp * 8 + 6]; el[7] = wave_sum(eb.w) + be[grp * 8 + 7];
        int i1 = 0; float m1 = el[0];
#pragma unroll
        for (int i = 1; i < 8; ++i) if (el[i] > m1) { m1 = el[i]; i1 = i; }
        int i2 = -1; float m2 = -3.0e38f;
#pragma unroll
        for (int i = 0; i < 8; ++i) if (i != i1 && el[i] > m2) { m2 = el[i]; i2 = i; }
        const float r = expf(m2 - m1); const float w1 = ggate / (1.0f + r), w2 = ggate * r / (1.0f + r);
        if (lane == 0) {
            const int e1 = grp * 8 + i1, e2 = grp * 8 + i2;
            const int r1 = __hip_atomic_fetch_add(&lcnt[e1], 1, __ATOMIC_RELAXED, __HIP_MEMORY_SCOPE_WORKGROUP), r2 = __hip_atomic_fetch_add(&lcnt[e2], 1, __ATOMIC_RELAXED, __HIP_MEMORY_SCOPE_WORKGROUP);
            list[(rr * 2 + 0) * 4 + 0] = m * 2 + 0; list[(rr * 2 + 0) * 4 + 1] = e1; list[(rr * 2 + 0) * 4 + 2] = __float_as_int(w1); list[(rr * 2 + 0) * 4 + 3] = r1;
            list[(rr * 2 + 1) * 4 + 0] = m * 2 + 1; list[(rr * 2 + 1) * 4 + 1] = e2; list[(rr * 2 + 1) * 4 + 2] = __float_as_int(w2); list[(rr * 2 + 1) * 4 + 3] = r2;
        }
    }
    __syncthreads();
    if (tid < 32) { const int c = lcnt[tid]; lcnt[32 + tid] = c > 0 ? (int)__hip_atomic_fetch_add(cntg + tid * 64, (unsigned)c, RLX_AGENT) : 0; }
    __syncthreads();
    for (int i = tid; i < rows_per_blk * 2; i += NTHREADS) {
        const int p = list[i * 4 + 0], e = list[i * 4 + 1], wbits = list[i * 4 + 2], lr = list[i * 4 + 3];
        const int slot = lcnt[32 + e] + lr;
        slot_tok[(size_t)e * TOK + slot] = p; slot_w[(size_t)e * TOK + slot] = __int_as_float(wbits);
    }
}

__device__ __forceinline__ pg8::MoeTab moe_tables(Frame& F, int layer) {
    LAS int* cnt = (LAS int*)(F.lds + LDS_MOE_TAB); LAS int* ts = cnt + 32;
    const int tid = F.ftid();
    __syncthreads();
    if (tid < 32) cnt[tid] = (int)__hip_atomic_load(F.ctl + CW_CNT + (layer * 32 + tid) * 64, RLX_AGENT);
    __syncthreads();
    if (tid == 0) { int a = 0; for (int e = 0; e < 32; ++e) { ts[e] = a; a += (cnt[e] + 255) >> 8; } ts[32] = a; }
    __syncthreads();
    pg8::MoeTab T; T.cnt = cnt; T.tstart = ts; return T;
}

template <bool FINAL>
__device__ __forceinline__ void p_combine(Frame& F, float* xs, const float* gain, float* outp) {
    const bf16_t* y0 = (const bf16_t*)(F.ws + WS_Y); const bf16_t* y1 = y0 + (size_t)TOK * DM; bf16_t* hb = (bf16_t*)(F.ws + WS_H);
    const int lane = F.ftid() & 63;
    const int gw = F.vcu * NWAVES + F.wave, NGW = F.G * NWAVES;
    for (int m = gw; m < TOK; m += NGW) {
        GAS f32x4* xr = (GAS f32x4*)(xs + (size_t)m * DM) + lane; const GAS f32x4* gr = (const GAS f32x4*)gain + lane;
        const GAS u32x2* a0 = (const GAS u32x2*)(y0 + (size_t)m * DM) + lane; const GAS u32x2* a1 = (const GAS u32x2*)(y1 + (size_t)m * DM) + lane;
        f32x4 v[4]; float s = 0.f;
#pragma unroll
        for (int j = 0; j < 4; ++j) { v[j] = xr[64 * j]; const u32x2 p0 = a0[64 * j], p1 = a1[64 * j];
            v[j].x += bflo(p0.x) + bflo(p1.x); v[j].y += bfhi(p0.x) + bfhi(p1.x); v[j].z += bflo(p0.y) + bflo(p1.y); v[j].w += bfhi(p0.y) + bfhi(p1.y);
            s += (v[j].x * v[j].x + v[j].y * v[j].y) + (v[j].z * v[j].z + v[j].w * v[j].w); }
        const float inv = 1.0f / sqrtf(wave_sum(s) * (1.f / DM) + EPS);
        if constexpr (FINAL) {
            GAS f32x4* op = (GAS f32x4*)(outp + (size_t)m * DM) + lane;
#pragma unroll
            for (int j = 0; j < 4; ++j) { const f32x4 gg = gr[64 * j]; op[64 * j] = (f32x4){v[j].x * inv * gg.x, v[j].y * inv * gg.y, v[j].z * inv * gg.z, v[j].w * inv * gg.w}; }
        } else {
            GAS u32x2* o8 = (GAS u32x2*)(hb + (size_t)m * DM) + lane;
#pragma unroll
            for (int j = 0; j < 4; ++j) { xr[64 * j] = v[j]; const f32x4 gg = gr[64 * j]; u32x2 w; w.x = cvt_pk_bf16(v[j].x * inv * gg.x, v[j].y * inv * gg.y); w.y = cvt_pk_bf16(v[j].z * inv * gg.z, v[j].w * inv * gg.w); o8[64 * j] = w; }
        }
    }
}

__device__ __forceinline__ void p_pool(Frame& F) {
    const bf16_t* hb = (const bf16_t*)(F.ws + WS_H); bf16_t* pb = (bf16_t*)(F.ws + WS_POOLED);
    const int tidp = F.ftid();
    const int c0 = tidp * 2; const int w = 2 << (c0 >> 8);
    for (int tile = F.vcu; tile < TOK / 64; tile += F.G) {
        const int t0 = tile * 64; const int pos0 = t0 & (SEQ - 1);
        float s0 = 0.f, s1 = 0.f;
        for (int d = 1; d <= w; ++d) if (pos0 - d >= 0) { const unsigned u = *(const unsigned*)(hb + (size_t)(t0 - d) * DM + c0); s0 += bflo(u); s1 += bfhi(u); }
        for (int i = 0; i < 64; ++i) {
            const int pos = pos0 + i; const unsigned u = *(const unsigned*)(hb + (size_t)(t0 + i) * DM + c0);
            const float h0 = bflo(u), h1 = bfhi(u); s0 += h0; s1 += h1;
            if (pos - w >= 0) { const unsigned uo = *(const unsigned*)(hb + (size_t)(t0 + i - w) * DM + c0); s0 -= bflo(uo); s1 -= bfhi(uo); }
            const float rc = 1.0f / (float)(pos + 1 < w ? pos + 1 : w);
            *(unsigned*)(pb + (size_t)(t0 + i) * DM + c0) = cvt_pk_bf16(s0 * rc - h0, s1 * rc - h1);
        }
    }
}

struct Args { const float* in[15]; float* out; unsigned char* ws; int ph_lo, ph_hi; };
constexpr int N_PHASES = 15;

__global__ void __launch_bounds__(NTHREADS, 2) mk_fwd(Args args) {
    extern __shared__ __attribute__((aligned(16))) unsigned char lds_raw[];
    Frame F;
    F.lds = (LAS unsigned char*)lds_raw;
    F.MISC = (volatile LAS unsigned*)(F.lds + MISC_OFF);
    F.wave = __builtin_amdgcn_readfirstlane(threadIdx.x >> 6);
    F.G = gridDim.x; { const int bx = blockIdx.x; F.vcu = (F.G % 8 == 0) ? (bx % 8) * (F.G / 8) + bx / 8 : bx; }
    F.ws = args.ws; F.out = args.out; F.ctl = (unsigned*)(args.ws + WS_CTL);
    F.x = args.in[0]; F.norm_mix = args.in[1]; F.norm_ffn = args.in[2]; F.ret_w_in = args.in[3]; F.ret_w_out = args.in[4]; F.pool_w = args.in[5]; F.pool_scale = args.in[6];
    F.moe_w_group = args.in[7]; F.moe_b_group = args.in[8]; F.moe_w_expert = args.in[9]; F.moe_b_expert = args.in[10]; F.moe_w_gate = args.in[11]; F.moe_w_up = args.in[12]; F.moe_w_down = args.in[13]; F.final_norm = args.in[14];
    for (int u = threadIdx.x; u < (LDS_BYTES - LDSCTL_OFF) / 4; u += NTHREADS) ((LAS unsigned*)(F.lds + LDSCTL_OFF))[u] = 0u;
    __syncthreads();
    XcdBarrier bar; bar.bar = (unsigned*)(F.ctl + CW_BAR); bar.x = 0; bar.st = nullptr;
#if !MK_PER_PHASE
    bar = xcd_barrier_post((unsigned*)(F.ctl + CW_BAR), F.MISC + 8);
#endif
    const int lo = args.ph_lo, hi = args.ph_hi;
#ifndef PH_MASK
#define PH_MASK 0x7fff
#endif
#define IN(k) (((PH_MASK >> (k)) & 1) && lo <= (k) && (k) < hi)
#define SEAM(k) do { if (IN(k) && IN((k) + 1)) xcd_barrier(bar); } while (0)
    float* x1 = (float*)(F.ws + WS_X1);
    bf16_t* hbuf = (bf16_t*)(F.ws + WS_H);

    if (IN(0)) { p0_prologue(F); } SEAM(0);

    if (IN(1)) {
        pg8::DenseSched S; S.init((const bf16_t*)F.out, (const bf16_t*)(F.ws + WS_WIN), DM, DM, 0, TOK, NIN, F.G, (int)blockIdx.x);
        pg8::EpiQKVG E{(bf16_t*)(F.ws + WS_Q), (bf16_t*)(F.ws + WS_K), (bf16_t*)(F.ws + WS_V), (bf16_t*)(F.ws + WS_G), (const float*)(F.ws + WS_ROPE)};
        pg8::gemm_phase<pg8::EpiQKVG, pg8::DenseSched, true>(F.lds, DM, S, E);
    } SEAM(1);

    if (IN(2)) {
#if RET_NAIVE
        p2_retention_naive(F);
#endif
    } SEAM(2);

    if (IN(3)) { p3_gating(F); } SEAM(3);

    if (IN(4)) {
        pg8::DenseSched S; S.init((const bf16_t*)F.out, (const bf16_t*)(F.ws + WS_WOUT), VD, VD, 0, TOK, DM, F.G, (int)blockIdx.x);
        pg8::EpiResid E{F.x, x1, nullptr};
        pg8::gemm_phase<pg8::EpiResid, pg8::DenseSched, true>(F.lds, VD, S, E);
    } SEAM(4);

#define MOE_LAYER(layer, pb) do { \
        if (IN(pb)) { \
            p_router(F, x1, F.norm_ffn + (layer) * DM, F.moe_w_group + (size_t)(layer) * DM * 4, F.moe_b_group + (layer) * 4, F.moe_w_expert + (size_t)(layer) * DM * 32, F.moe_b_expert + (layer) * 32, (layer)); \
        } SEAM(pb); \
        if (IN((pb) + 1)) { \
            const pg8::MoeTab T = moe_tables(F, (layer)); \
            pg8::EpiGateUp E{(bf16_t*)(F.ws + WS_HID)}; \
            for (int i = 0;; ++i) { \
                pg8::MoeGuSched S; S.H = hbuf; S.W = (const bf16_t*)(F.ws + WS_WGU) + (size_t)(layer) * 32 * 512 * DM; S.slot_tok = (const int*)(F.ws + WS_SLOT_TOK); S.T = T; S.L = i * F.G + F.vcu; S.lda = DM; S.ldb = DM; \
                pg8::Unit u; if (!S.next(0, u)) break; \
                pg8::gemm_phase<pg8::EpiGateUp, pg8::MoeGuSched, false>(F.lds, DM, S, E); \
            } \
        } SEAM((pb) + 1); \
        if (IN((pb) + 2)) { \
            const pg8::MoeTab T = moe_tables(F, (layer)); \
            pg8::MoeDownSched S; S.HID = (const bf16_t*)(F.ws + WS_HID); S.W = (const bf16_t*)(F.ws + WS_WD) + (size_t)(layer) * 32 * DM * DFF; S.T = T; S.G = F.G; S.c = F.vcu; S.lda = DFF; S.ldb = DFF; \
            pg8::EpiDown E{(bf16_t*)(F.ws + WS_Y), (const int*)(F.ws + WS_SLOT_TOK), (const float*)(F.ws + WS_SLOT_W), T}; \
            pg8::gemm_phase<pg8::EpiDown, pg8::MoeDownSched, true>(F.lds, DFF, S, E); \
        } SEAM((pb) + 2); \
    } while (0)

    MOE_LAYER(0, 5);
    if (IN(8)) { p_combine<false>(F, x1, F.norm_mix + DM, nullptr); } SEAM(8);
    if (IN(9)) { p_pool(F); } SEAM(9);
    if (IN(10)) {
        pg8::DenseSched S; S.init((const bf16_t*)(F.ws + WS_POOLED), (const bf16_t*)(F.ws + WS_WPOOL), DM, 256, 256, TOK, DM, F.G, (int)blockIdx.x);
        pg8::EpiResid E{x1, x1, F.pool_scale};
        pg8::gemm_phase<pg8::EpiResid, pg8::DenseSched, true>(F.lds, 256, S, E);
    } SEAM(10);
    MOE_LAYER(1, 11);
#undef MOE_LAYER
    if (IN(14)) { p_combine<true>(F, x1, F.final_norm, F.out); }
#undef IN
#undef SEAM
}

extern "C" void kernel_launch(void* const* d_in, const int* in_sizes, int n_in, void* d_out, int out_size, void* d_ws, size_t ws_size, hipStream_t stream) {
    static int grid = 0;
    if (grid == 0) {
        if (n_in != 15 || in_sizes[0] != TOK * DM || out_size != TOK * DM || ws_size < WS_END) { fprintf(stderr, "kernel_launch: unexpected shapes/workspace (n_in %d, ws %zu)\n", n_in, ws_size); grid = -1; return; }
        int dev = 0, cus = 0, per_cu = 0;
        if (hipGetDevice(&dev) != hipSuccess || hipDeviceGetAttribute(&cus, hipDeviceAttributeMultiprocessorCount, dev) != hipSuccess) { grid = -1; return; }
        if (hipFuncSetAttribute((const void*)mk_fwd, hipFuncAttributeMaxDynamicSharedMemorySize, LDS_BYTES) != hipSuccess) { fprintf(stderr, "kernel_launch: hipFuncSetAttribute failed\n"); grid = -1; return; }
        if (hipOccupancyMaxActiveBlocksPerMultiprocessor(&per_cu, (const void*)mk_fwd, NTHREADS, LDS_BYTES) != hipSuccess || per_cu < 1) { fprintf(stderr, "kernel_launch: occupancy query says %d blocks/CU\n", per_cu); grid = -1; (void)hipGetLastError(); return; }
        grid = cus;
        if (grid > 256) grid = 256;
    }
    if (grid < 0) return;
    if (hipMemsetAsync((char*)d_ws + WS_CTL, 0, CTL_ZERO_BYTES, stream) != hipSuccess) return;
    Args a{};
    for (int i = 0; i < 15; ++i) a.in[i] = (const float*)d_in[i];
    a.out = (float*)d_out; a.ws = (unsigned char*)d_ws;
#if MK_PER_PHASE
    for (int p = 0; p < N_PHASES; ++p) { a.ph_lo = p; a.ph_hi = p + 1; hipLaunchKernelGGL(mk_fwd, dim3(grid), dim3(NTHREADS), LDS_BYTES, stream, a); }
#else
    a.ph_lo = 0; a.ph_hi = N_PHASES;
    hipLaunchKernelGGL(mk_fwd, dim3(grid), dim3(NTHREADS), LDS_BYTES, stream, a);
#endif
}
```

```cpp
#include <hip/hip_runtime.h>
#include <cstdio>
#include <cstdint>

#ifndef MK_PER_PHASE
#define MK_PER_PHASE 0
#endif
#ifndef RET_NAIVE
#define RET_NAIVE 1
#endif

#define GAS __attribute__((address_space(1)))
#define LAS __attribute__((address_space(3)))
typedef unsigned short bf16_t;
typedef short bf16x8 __attribute__((ext_vector_type(8)));
typedef float f32x4 __attribute__((ext_vector_type(4)));
typedef float f32x2 __attribute__((ext_vector_type(2)));
typedef unsigned u32x4 __attribute__((ext_vector_type(4)));
typedef unsigned u32x2 __attribute__((ext_vector_type(2)));

constexpr int BATCH = 8, SEQ = 4096, DM = 1024, TOK = BATCH * SEQ;
constexpr int NH = 4, DK = 256, DV = 512, QKD = 1024, VD = 2048, NIN = 6144;
constexpr int NE = 32, EPG = 8, DFF = 256;
constexpr int CHUNK = 64, NCHUNK = SEQ / CHUNK;
constexpr float EPS = 1e-6f;
constexpr int NWAVES = 8, NTHREADS = 512;

constexpr size_t MiB = 1u << 20;
constexpr size_t WS_CTL = 0, CTL_ZERO_BYTES = 1 * MiB;
constexpr size_t WS_ROPE = 1 * MiB;
constexpr size_t WS_STATS = 503 * MiB;
constexpr size_t WS_WIN = 6 * MiB;
constexpr size_t WS_WOUT = 18 * MiB;
constexpr size_t WS_WPOOL = 22 * MiB;
constexpr size_t WS_WGU = 23 * MiB;
constexpr size_t WS_WD = 87 * MiB;
constexpr size_t WS_Q = 119 * MiB;
constexpr size_t WS_K = 183 * MiB;
constexpr size_t WS_V = 247 * MiB;
constexpr size_t WS_G = 375 * MiB;
constexpr size_t WS_X1 = 119 * MiB;
constexpr size_t WS_H = 247 * MiB;
constexpr size_t WS_HID = 311 * MiB;
constexpr size_t WS_Y = 349 * MiB;
constexpr size_t WS_POOLED = 349 * MiB;
constexpr size_t WS_SLOT_TOK = 477 * MiB;
constexpr size_t WS_SLOT_W = 481 * MiB;
constexpr size_t WS_END = 511 * MiB;
constexpr int CW_TMO = 0, CW_CODE = 1;
constexpr int CW_BAR = 4096;
constexpr int CW_CNT = 16384;

constexpr int RING_BYTES = 131072;
constexpr int LDS_MOE_TAB = 131072;
constexpr int LDS_RT_LIST = 147456;
constexpr int LDS_RT_CNT = 151552;
constexpr int LDSCTL_OFF = 151808, MISC_OFF = LDSCTL_OFF + 64;
constexpr int LDS_BYTES = 155648;

#define LDS_WAIT() asm volatile("s_waitcnt lgkmcnt(0)" ::: "memory")
#define VM_WAIT() asm volatile("s_waitcnt vmcnt(0)" ::: "memory")
#define RLX_AGENT __ATOMIC_RELAXED, __HIP_MEMORY_SCOPE_AGENT

__device__ __forceinline__ unsigned cvt_pk_bf16(float lo, float hi) { unsigned r; asm volatile("v_cvt_pk_bf16_f32 %0, %1, %2" : "=v"(r) : "v"(lo), "v"(hi)); return r; }
__device__ __forceinline__ float bf2f(unsigned short u) { return __uint_as_float(((unsigned)u) << 16); }
__device__ __forceinline__ float bflo(unsigned u) { return __uint_as_float(u << 16); }
__device__ __forceinline__ float bfhi(unsigned u) { return __uint_as_float(u & 0xffff0000u); }
__device__ __forceinline__ float wave_sum(float v) {
#pragma unroll
    for (int o = 1; o < 64; o <<= 1) v += __shfl_xor(v, o);
    return v;
}
__device__ __forceinline__ float silu_f(float x) { return x / (1.0f + __expf(-x)); }

namespace pg8 {
constexpr int BM = 256, BK = 64, HALF = 128, HTB = HALF * BK * 2, STAGE_BYTES = 8 * HTB, NXCD = 8, WGM = 8;
__host__ __device__ __forceinline__ int lds_byte(int r, int c) { const int st = (r >> 4) * 2 + (c >> 5), rr = r & 15, cc = c & 31, ob = rr * 64 + cc * 2; return st * 1024 + (ob ^ (((ob >> 9) & 1) << 5)); }
__host__ __device__ __forceinline__ void stage_rc(int b, int& R, int& C) { const int st = b / 1024, sb = b % 1024, swz = sb ^ (((sb >> 9) & 1) << 5); R = (st >> 1) * 16 + swz / 64; C = (st & 1) * 32 + (swz % 64) / 2; }
__host__ __device__ __forceinline__ int perm32(int rho) { const int n = rho >> 4, i = rho & 15; return 8 * (i >> 2) + 4 * n + (i & 3); }

struct Unit { int pm, pn, e, r; };

struct DenseSched {
    static constexpr bool GATHER = false;
    const bf16_t* A; const bf16_t* Bt; int lda, ldb, a_col_stride;
    int nM, nN, nwg, G, c;
    __device__ void init(const bf16_t* A_, const bf16_t* Bt_, int lda_, int ldb_, int acs, int M, int N, int G_, int c_) {
        A = A_; Bt = Bt_; lda = lda_; ldb = ldb_; a_col_stride = acs; nM = M / BM; nN = N / BM; nwg = nM * nN; G = G_; c = c_; }
    __device__ bool next(int i, Unit& u) const {
        const long L = (long)i * G + c; if (L >= nwg) return false;
        int wgid = (int)L; { const int q = nwg / NXCD, r = nwg % NXCD, xcd = wgid % NXCD, off = wgid / NXCD; wgid = (xcd < r ? xcd * (q + 1) : r * (q + 1) + (xcd - r) * q) + off; }
        const int nig = WGM * nN, gid = wgid / nig, fm = gid * WGM, gsz = (nM - fm) < WGM ? (nM - fm) : WGM;
        u.pm = fm + ((wgid % nig) % gsz); u.pn = (wgid % nig) / gsz; u.e = 0; u.r = 0; return true;
    }
    __device__ __forceinline__ const char* a_base(const Unit& u) const { return (const char*)(A + (size_t)u.pm * BM * lda + (size_t)u.pn * a_col_stride); }
    __device__ __forceinline__ const char* b_base(const Unit& u) const { return (const char*)(Bt + (size_t)u.pn * BM * ldb); }
    __device__ __forceinline__ unsigned a_row_off(const Unit&, int) const { return 0u; }
};

struct MoeTab { const LAS int* cnt; const LAS int* tstart; };
__device__ __forceinline__ bool moe_unit(const MoeTab& T, int L, int NT, Unit& u) {
    const int total = T.tstart[32];
    if (L >= total * NT) return false;
    const int tile = L / NT; u.pn = L - tile * NT; u.pm = tile;
    int e = 0;
#pragma unroll 1
    for (int j = 1; j < 32; ++j) if (T.tstart[j] <= tile) e = j;
    u.e = e; u.r = tile - T.tstart[e]; return true;
}
struct MoeGuSched {
    static constexpr bool GATHER = true;
    const bf16_t* H; const bf16_t* W; const int* slot_tok; MoeTab T; int L;
    int lda, ldb;
    __device__ bool next(int i, Unit& u) const { if (i != 0) return false; return moe_unit(T, L, 2, u); }
    __device__ __forceinline__ const char* a_base(const Unit&) const { return (const char*)H; }
    __device__ __forceinline__ const char* b_base(const Unit& u) const { return (const char*)(W + ((size_t)u.e * 512 + (size_t)u.pn * 256) * 1024); }
    __device__ __forceinline__ unsigned a_row_off(const Unit& u, int row) const {
        const int slot = u.r * 256 + row; int tok = 0;
        if (slot < T.cnt[u.e]) tok = slot_tok[(size_t)u.e * TOK + slot] >> 1;
        return (unsigned)tok * (unsigned)(DM * 2);
    }
};
struct MoeDownSched {
    static constexpr bool GATHER = false;
    const bf16_t* HID; const bf16_t* W; MoeTab T; int G, c;
    int lda, ldb;
    __device__ bool next(int i, Unit& u) const { return moe_unit(T, i * G + c, 4, u); }
    __device__ __forceinline__ const char* a_base(const Unit& u) const { return (const char*)(HID + (size_t)u.pm * 256 * DFF); }
    __device__ __forceinline__ const char* b_base(const Unit& u) const { return (const char*)(W + ((size_t)u.e * 1024 + (size_t)u.pn * 256) * DFF); }
    __device__ __forceinline__ unsigned a_row_off(const Unit&, int) const { return 0u; }
};


struct EpiQKVG {
    static constexpr bool PERM = true;
    bf16_t *q, *k, *v, *g; const float* rope;
    __device__ __forceinline__ void operator()(const f32x4 (&acc)[2][2][4][2], const Unit& u, int wr, int wc, int fr_in, int fq_in) const {
        int fr = fr_in, fq = fq_in; asm volatile("" : "+v"(fr), "+v"(fq));
        const int pn = u.pn, row0 = u.pm * BM + wr * 64 + fr, cl = wc * 32 + 8 * fq;
        if (pn < 8) {
            bf16_t* dst = (pn < 4 ? q : k) + (size_t)(pn & 3) * 256 + cl;
            const float sc = pn < 4 ? 1.0f : 0.0625f;
#pragma unroll
            for (int ai = 0; ai < 2; ++ai)
#pragma unroll
                for (int m = 0; m < 4; ++m) {
                    const int row = row0 + ai * HALF + m * 16, pos = row & (SEQ - 1);
                    const f32x4* tp = (const f32x4*)(rope + ((size_t)pos * 128 + cl) * 2);
                    const f32x4 t0 = tp[0], t1 = tp[1], t2 = tp[2], t3 = tp[3];
                    const f32x4 a0 = acc[ai][0][m][0], a1 = acc[ai][0][m][1], b0 = acc[ai][1][m][0], b1 = acc[ai][1][m][1];
                    float o1[8], o2[8];
                    o1[0] = a0[0] * t0[0] - b0[0] * t0[1]; o2[0] = a0[0] * t0[1] + b0[0] * t0[0];
                    o1[1] = a0[1] * t0[2] - b0[1] * t0[3]; o2[1] = a0[1] * t0[3] + b0[1] * t0[2];
                    o1[2] = a0[2] * t1[0] - b0[2] * t1[1]; o2[2] = a0[2] * t1[1] + b0[2] * t1[0];
                    o1[3] = a0[3] * t1[2] - b0[3] * t1[3]; o2[3] = a0[3] * t1[3] + b0[3] * t1[2];
                    o1[4] = a1[0] * t2[0] - b1[0] * t2[1]; o2[4] = a1[0] * t2[1] + b1[0] * t2[0];
                    o1[5] = a1[1] * t2[2] - b1[1] * t2[3]; o2[5] = a1[1] * t2[3] + b1[1] * t2[2];
                    o1[6] = a1[2] * t3[0] - b1[2] * t3[1]; o2[6] = a1[2] * t3[1] + b1[2] * t3[0];
                    o1[7] = a1[3] * t3[2] - b1[3] * t3[3]; o2[7] = a1[3] * t3[3] + b1[3] * t3[2];
                    u32x4 w1, w2;
                    w1.x = cvt_pk_bf16(o1[0] * sc, o1[1] * sc); w1.y = cvt_pk_bf16(o1[2] * sc, o1[3] * sc); w1.z = cvt_pk_bf16(o1[4] * sc, o1[5] * sc); w1.w = cvt_pk_bf16(o1[6] * sc, o1[7] * sc);
                    w2.x = cvt_pk_bf16(o2[0] * sc, o2[1] * sc); w2.y = cvt_pk_bf16(o2[2] * sc, o2[3] * sc); w2.z = cvt_pk_bf16(o2[4] * sc, o2[5] * sc); w2.w = cvt_pk_bf16(o2[6] * sc, o2[7] * sc);
                    bf16_t* rp = dst + (size_t)row * QKD;
                    *(u32x4*)(rp) = w1; *(u32x4*)(rp + HALF) = w2;
                }
        } else {
            bf16_t* dst = (pn < 16 ? v + (size_t)(pn - 8) * 256 : g + (size_t)(pn - 16) * 256) + cl;
#pragma unroll
            for (int ai = 0; ai < 2; ++ai)
#pragma unroll
                for (int m = 0; m < 4; ++m) {
                    bf16_t* rp = dst + (size_t)(row0 + ai * HALF + m * 16) * VD;
#pragma unroll
                    for (int bj = 0; bj < 2; ++bj) { const f32x4 v0 = acc[ai][bj][m][0], v1 = acc[ai][bj][m][1];
                        u32x4 w; w.x = cvt_pk_bf16(v0[0], v0[1]); w.y = cvt_pk_bf16(v0[2], v0[3]); w.z = cvt_pk_bf16(v1[0], v1[1]); w.w = cvt_pk_bf16(v1[2], v1[3]);
                        *(u32x4*)(rp + bj * HALF) = w; }
                }
        }
    }
};
struct EpiResid {
    static constexpr bool PERM = false;
    const float* base; float* out; const float* scale;
    __device__ __forceinline__ void operator()(const f32x4 (&acc)[2][2][4][2], const Unit& u, int wr, int wc, int fr_in, int fq_in) const {
        int fr = fr_in, fq = fq_in; asm volatile("" : "+v"(fr), "+v"(fq));
        const int col0 = u.pn * BM + wc * 32 + 4 * fq;
        f32x4 sv[2][2];
#pragma unroll
        for (int bj = 0; bj < 2; ++bj)
#pragma unroll
            for (int n = 0; n < 2; ++n) sv[bj][n] = scale ? *(const f32x4*)(scale + col0 + bj * HALF + n * 16) : (f32x4){1.f, 1.f, 1.f, 1.f};
#pragma unroll
        for (int ai = 0; ai < 2; ++ai)
#pragma unroll
            for (int m = 0; m < 4; ++m) { const size_t off = (size_t)(u.pm * BM + ai * HALF + wr * 64 + m * 16 + fr) * DM + col0;
#pragma unroll
                for (int bj = 0; bj < 2; ++bj)
#pragma unroll
                    for (int n = 0; n < 2; ++n) { const f32x4 bs = *(const f32x4*)(base + off + bj * HALF + n * 16);
                        *(f32x4*)(out + off + bj * HALF + n * 16) = bs + acc[ai][bj][m][n] * sv[bj][n]; } }
    }
};
struct EpiGateUp {
    static constexpr bool PERM = true;
    bf16_t* hid;
    __device__ __forceinline__ void operator()(const f32x4 (&acc)[2][2][4][2], const Unit& u, int wr, int wc, int fr_in, int fq_in) const {
        int fr = fr_in, fq = fq_in; asm volatile("" : "+v"(fr), "+v"(fq));
        bf16_t* dst = hid + (size_t)u.pm * 256 * DFF + u.pn * 128 + wc * 32 + 8 * fq;
#pragma unroll
        for (int ai = 0; ai < 2; ++ai)
#pragma unroll
            for (int m = 0; m < 4; ++m) {
                const f32x4 g0 = acc[ai][0][m][0], g1 = acc[ai][0][m][1], u0 = acc[ai][1][m][0], u1 = acc[ai][1][m][1];
                u32x4 w;
                w.x = cvt_pk_bf16(silu_f(g0[0]) * u0[0], silu_f(g0[1]) * u0[1]); w.y = cvt_pk_bf16(silu_f(g0[2]) * u0[2], silu_f(g0[3]) * u0[3]);
                w.z = cvt_pk_bf16(silu_f(g1[0]) * u1[0], silu_f(g1[1]) * u1[1]); w.w = cvt_pk_bf16(silu_f(g1[2]) * u1[2], silu_f(g1[3]) * u1[3]);
                *(u32x4*)(dst + (size_t)(ai * HALF + wr * 64 + m * 16 + fr) * DFF) = w;
            }
    }
};
struct EpiDown {
    static constexpr bool PERM = true;
    bf16_t* y; const int* slot_tok; const float* slot_w; MoeTab T;
    __device__ __forceinline__ void operator()(const f32x4 (&acc)[2][2][4][2], const Unit& u, int wr, int wc, int fr_in, int fq_in) const {
        int fr = fr_in, fq = fq_in; asm volatile("" : "+v"(fr), "+v"(fq));
        const int cnt = T.cnt[u.e]; const int cl = u.pn * BM + wc * 32 + 8 * fq;
#pragma unroll
        for (int ai = 0; ai < 2; ++ai)
#pragma unroll
            for (int m = 0; m < 4; ++m) {
                const int slot = u.r * 256 + ai * HALF + wr * 64 + m * 16 + fr;
                if (slot < cnt) {
                    const int p = slot_tok[(size_t)u.e * TOK + slot]; const float w = slot_w[(size_t)u.e * TOK + slot];
                    bf16_t* rp = y + ((size_t)(p & 1) * TOK + (size_t)(p >> 1)) * DM + cl;
#pragma unroll
                    for (int bj = 0; bj < 2; ++bj) { const f32x4 v0 = acc[ai][bj][m][0] * w, v1 = acc[ai][bj][m][1] * w;
                        u32x4 o; o.x = cvt_pk_bf16(v0[0], v0[1]); o.y = cvt_pk_bf16(v0[2], v0[3]); o.z = cvt_pk_bf16(v1[0], v1[1]); o.w = cvt_pk_bf16(v1[2], v1[3]);
                        *(u32x4*)(rp + bj * HALF) = o; }
                }
            }
    }
};

template <class Epi, class Sched, bool ALIGN_EPI>
__device__ __forceinline__ void gemm_phase(LAS unsigned char* lds, const int K, const Sched& S, const Epi& E) {
    int tid = threadIdx.x; asm volatile("" : "+v"(tid));
    const int wid = __builtin_amdgcn_readfirstlane(tid >> 6), lane = tid & 63, wr = wid >> 2, wc = wid & 3, fr = lane & 15, fq = lane >> 4;
    const int nt = K / BK;
    const unsigned lda_b = (unsigned)S.lda * 2u, ldb_b = (unsigned)S.ldb * 2u;
    int Rs[2], Cs[2];
    unsigned voffA[2][2], voffB[2];
#pragma unroll
    for (int i = 0; i < 2; ++i) { stage_rc(tid * 16 + i * 8192, Rs[i], Cs[i]); const int Rb = Epi::PERM ? ((Rs[i] & ~31) + perm32(Rs[i] & 31)) : Rs[i];
        voffB[i] = (unsigned)Rb * ldb_b + (unsigned)Cs[i] * 2u;
        voffA[0][i] = (unsigned)Rs[i] * lda_b + (unsigned)Cs[i] * 2u; voffA[1][i] = voffA[0][i]; }
    const size_t kstep = (size_t)(BK * 2);
    const size_t hstepA = Sched::GATHER ? 0 : (size_t)HALF * lda_b;
    const size_t hstepB = (size_t)HALF * ldb_b;
    const unsigned ldsw = (unsigned)wid * 1024u;
    const int aoff = lds_byte(wr * 64 + fr, fq * 8), boff = lds_byte(wc * 32 + fr, fq * 8);
#define PG8_SA(b, h) (((b) * 2 + (h)) * HTB)
#define PG8_SB(b, h) ((4 + (b) * 2 + (h)) * HTB)
#define PG8_STAGEA(bufoff, gbase, h) do { _Pragma("unroll") for (int _i = 0; _i < 2; ++_i) \
        __builtin_amdgcn_global_load_lds((const unsigned*)((const char*)(gbase) + voffA[h][_i]), (LAS unsigned*)(lds + (bufoff) + ldsw + _i * 8192), 16, 0, 0); } while (0)
#define PG8_STAGEB(bufoff, gbase) do { _Pragma("unroll") for (int _i = 0; _i < 2; ++_i) \
        __builtin_amdgcn_global_load_lds((const unsigned*)((const char*)(gbase) + voffB[_i]), (LAS unsigned*)(lds + (bufoff) + ldsw + _i * 8192), 16, 0, 0); } while (0)
#define PG8_LDA(dst, b, h) do { _Pragma("unroll") for (int m = 0; m < 4; ++m) _Pragma("unroll") for (int k = 0; k < 2; ++k) dst[m][k] = *(const LAS bf16x8*)(lds + PG8_SA(b, h) + aoff + m * 2048 + k * 1024); } while (0)
#define PG8_LDB(dst, b, h) do { _Pragma("unroll") for (int n = 0; n < 2; ++n) _Pragma("unroll") for (int k = 0; k < 2; ++k) dst[n][k] = *(const LAS bf16x8*)(lds + PG8_SB(b, h) + boff + n * 2048 + k * 1024); } while (0)
#define PG8_MMA(ai, bj, At, Bt) do { __builtin_amdgcn_s_setprio(1); _Pragma("unroll") for (int m = 0; m < 4; ++m) _Pragma("unroll") for (int n = 0; n < 2; ++n) _Pragma("unroll") for (int k = 0; k < 2; ++k) \
        acc[ai][bj][m][n] = __builtin_amdgcn_mfma_f32_16x16x32_bf16(Bt[n][k], At[m][k], acc[ai][bj][m][n], 0, 0, 0); __builtin_amdgcn_s_setprio(0); } while (0)
#define PG8_WAIT_V(n) asm volatile("s_waitcnt vmcnt(" #n ")" ::: "memory")
#define PG8_WAIT_L(n) asm volatile("s_waitcnt lgkmcnt(" #n ")" ::: "memory")
#define PG8_BAR __builtin_amdgcn_s_barrier()
#define PG8_SCHED __builtin_amdgcn_sched_barrier(0)
    Unit cur, nxt; int ui = 0;
    if (!S.next(0, cur)) return;
    if constexpr (Sched::GATHER) {
#pragma unroll
        for (int h = 0; h < 2; ++h)
#pragma unroll
            for (int i = 0; i < 2; ++i) voffA[h][i] = S.a_row_off(cur, h * HALF + Rs[i]) + (unsigned)Cs[i] * 2u;
    }
    f32x4 acc[2][2][4][2];
#pragma unroll
    for (int a = 0; a < 2; ++a)
#pragma unroll
        for (int b = 0; b < 2; ++b)
#pragma unroll
            for (int m = 0; m < 4; ++m)
#pragma unroll
                for (int n = 0; n < 2; ++n) acc[a][b][m][n] = (f32x4){0.f, 0.f, 0.f, 0.f};
    bf16x8 At[4][2], B0[2][2], B1[2][2];
    const char* cA = S.a_base(cur); const char* cB = S.b_base(cur);
    PG8_STAGEB(PG8_SB(0, 0), cB); PG8_STAGEB(PG8_SB(0, 1), cB + hstepB); PG8_STAGEA(PG8_SA(0, 0), cA, 0); PG8_STAGEA(PG8_SA(0, 1), cA + hstepA, 1);
    if (wr == 1) PG8_BAR;
    PG8_WAIT_V(2); PG8_BAR;
    PG8_STAGEB(PG8_SB(1, 0), cB + kstep); PG8_STAGEA(PG8_SA(1, 0), cA + kstep, 0); PG8_STAGEB(PG8_SB(1, 1), cB + hstepB + kstep);
    PG8_WAIT_V(6); PG8_BAR;
    for (;;) {
        const bool has_next = Sched::GATHER ? false : S.next(ui + 1, nxt);
        const char* nA = has_next ? S.a_base(nxt) : cA; const char* nB = has_next ? S.b_base(nxt) : cB;
        for (int t = 0; t < nt; t += 2) {
            const bool last = (t == nt - 2);
            const char* a1 = cA + (size_t)(t + 1) * kstep;
            const char* a2 = last ? nA : cA + (size_t)(t + 2) * kstep; const char* b2 = last ? nB : cB + (size_t)(t + 2) * kstep;
            const char* a3 = a2 + kstep; const char* b3 = b2 + kstep;
            PG8_LDB(B0, 0, 0); PG8_LDB(B1, 0, 1); PG8_SCHED; PG8_LDA(At, 0, 0); PG8_STAGEA(PG8_SA(1, 1), a1 + hstepA, 1);
            PG8_WAIT_V(8); PG8_WAIT_L(0); PG8_BAR; PG8_MMA(0, 0, At, B0); PG8_MMA(0, 1, At, B1); PG8_BAR; PG8_SCHED;
            PG8_LDA(At, 0, 1); PG8_STAGEB(PG8_SB(0, 0), b2); PG8_STAGEB(PG8_SB(0, 1), b2 + hstepB); PG8_STAGEA(PG8_SA(0, 0), a2, 0);
            PG8_WAIT_V(8); PG8_WAIT_L(0); PG8_BAR; PG8_MMA(1, 0, At, B0); PG8_MMA(1, 1, At, B1); PG8_BAR; PG8_SCHED;
            PG8_LDB(B0, 1, 0); PG8_LDB(B1, 1, 1); PG8_SCHED; PG8_LDA(At, 1, 0); PG8_STAGEA(PG8_SA(0, 1), a2 + hstepA, 1);
            PG8_WAIT_V(8); PG8_WAIT_L(0); PG8_BAR; PG8_MMA(0, 0, At, B0); PG8_MMA(0, 1, At, B1); PG8_BAR; PG8_SCHED;
            PG8_LDA(At, 1, 1); PG8_STAGEB(PG8_SB(1, 0), b3); PG8_STAGEB(PG8_SB(1, 1), b3 + hstepB); PG8_STAGEA(PG8_SA(1, 0), a3, 0);
            PG8_WAIT_V(8); PG8_WAIT_L(0); PG8_BAR; PG8_MMA(1, 0, At, B0); PG8_MMA(1, 1, At, B1); PG8_BAR; PG8_SCHED;
        }
        if constexpr (ALIGN_EPI) { if (wr == 0) PG8_BAR; }
        E(acc, cur, wr, wc, fr, fq);
        if (!has_next) break;
#pragma unroll
        for (int a = 0; a < 2; ++a)
#pragma unroll
            for (int b = 0; b < 2; ++b)
#pragma unroll
                for (int m = 0; m < 4; ++m)
#pragma unroll
                    for (int n = 0; n < 2; ++n) acc[a][b][m][n] = (f32x4){0.f, 0.f, 0.f, 0.f};
        cur = nxt; cA = nA; cB = nB; ++ui;
        if constexpr (ALIGN_EPI) { if (wr == 1) PG8_BAR; }
    }
    PG8_WAIT_V(0);
    if constexpr (!ALIGN_EPI) { if (wr == 0) PG8_BAR; }
    PG8_BAR;
#undef PG8_SA
#undef PG8_SB
#undef PG8_STAGEA
#undef PG8_STAGEB
#undef PG8_LDA
#undef PG8_LDB
#undef PG8_MMA
#undef PG8_WAIT_V
#undef PG8_WAIT_L
#undef PG8_BAR
#undef PG8_SCHED
}
}

#define XB_TMO      128
#define XB_XCNT(j)  (256  + 64 * (j))
#define XB_XSUB(j)  (1280 + 64 * (j))
#define XB_XGEN(j)  (2304 + 64 * (j))
#define XB_TOP      3328
#define XB_TOPGEN   3392
#define XCD_BAR_WORDS 3456
#define XB_SPIN_CAP (1u << 18)
__device__ __forceinline__ unsigned xb_ld(unsigned* p)              { return __hip_atomic_load(p, __ATOMIC_RELAXED, __HIP_MEMORY_SCOPE_AGENT); }
__device__ __forceinline__ unsigned xb_add(unsigned* p, unsigned v) { return __hip_atomic_fetch_add(p, v, __ATOMIC_RELAXED, __HIP_MEMORY_SCOPE_AGENT); }
__device__ __forceinline__ unsigned xb_xcc_id() { return (unsigned)__builtin_amdgcn_s_getreg((3 << 11) | 20) & 0xFu; }
#define XB_SPIN(cond, bar) do { unsigned _sp = 0; while (cond) { __builtin_amdgcn_s_sleep(1); \
    if ((++_sp & 255u) == 0u) { if (xb_ld(&(bar)[XB_TMO])) break; if (_sp > XB_SPIN_CAP) { atomicAdd(&(bar)[XB_TMO], 1u); break; } } } } while (0)
struct XcdBarrier { unsigned* bar; unsigned x; volatile LAS unsigned* st; };
__device__ __forceinline__ XcdBarrier xcd_barrier_post(unsigned* bar, volatile LAS unsigned* st) {
    XcdBarrier b; b.bar = bar; b.x = xb_xcc_id(); b.st = st;
    if (threadIdx.x == 0) (void)xb_add(&bar[XB_XCNT(b.x)], 1u);
    return b;
}
__device__ __forceinline__ void xcd_barrier_complete(unsigned* bar, unsigned x, unsigned& nloc, unsigned& nx) {
    const unsigned G = gridDim.x * gridDim.y * gridDim.z;
    unsigned sum, cnt, mine, sp = 0u;
    for (;;) {
        sum = 0u; cnt = 0u; mine = 0u;
#pragma unroll
        for (unsigned j = 0; j < 16; ++j) { const unsigned c = xb_ld(&bar[XB_XCNT(j)]); sum += c; cnt += (c > 0u) ? 1u : 0u; mine = (j == x) ? c : mine; }
        if (sum == G) break;
        __builtin_amdgcn_s_sleep(1);
        if ((++sp & 255u) == 0u) { if (xb_ld(&bar[XB_TMO])) break; if (sp > XB_SPIN_CAP) { atomicAdd(&bar[XB_TMO], 1u); break; } }
    }
    nloc = mine > 0u ? mine : 1u; nx = cnt > 0u ? cnt : 1u;
}
__device__ __forceinline__ void xcd_barrier(const XcdBarrier& b) {
    asm volatile("s_waitcnt vmcnt(0)" ::: "memory");
    __syncthreads();
    if (threadIdx.x == 0) {
        unsigned* bar = b.bar;
        __builtin_amdgcn_s_waitcnt(0);
        unsigned nloc = b.st[0], nx = b.st[1];
        if (nloc == 0u) { xcd_barrier_complete(bar, b.x, nloc, nx); b.st[0] = nloc; b.st[1] = nx; }
        const unsigned old = xb_add(&bar[XB_XSUB(b.x)], 1u);
        const unsigned gen = old / nloc;
        if (old + 1u == (gen + 1u) * nloc) {
            __builtin_amdgcn_fence(__ATOMIC_RELEASE, "agent");
            asm volatile("s_waitcnt vmcnt(0)" ::: "memory");
            const unsigned og = xb_add(&bar[XB_TOP], 1u);
            const unsigned tg = og / nx;
            if (og + 1u == (tg + 1u) * nx) xb_add(&bar[XB_TOPGEN], 1u);
            else XB_SPIN(xb_ld(&bar[XB_TOPGEN]) == tg, bar);
            __builtin_amdgcn_fence(__ATOMIC_ACQUIRE, "agent");
            xb_add(&bar[XB_XGEN(b.x)], 1u);
            asm volatile("s_waitcnt vmcnt(0)" ::: "memory");
        } else {
            XB_SPIN(xb_ld(&bar[XB_XGEN(b.x)]) == gen, bar);
            __builtin_amdgcn_fence(__ATOMIC_ACQUIRE, "agent");
            asm volatile("s_waitcnt vmcnt(0)" ::: "memory");
        }
    }
    __syncthreads();
}

struct Frame {
    LAS unsigned char* lds;
    volatile LAS unsigned* MISC;
    unsigned* ctl;
    int wave, vcu, G;
    __device__ __forceinline__ int ftid() const { int t = threadIdx.x; asm volatile("" : "+v"(t)); return t; }
    unsigned char* ws; float* out;
    const float *x, *norm_mix, *norm_ffn, *ret_w_in, *ret_w_out, *pool_w, *pool_scale, *moe_w_group, *moe_b_group, *moe_w_expert, *moe_b_expert, *moe_w_gate, *moe_w_up, *moe_w_down, *final_norm;
};

__device__ __forceinline__ void p0_transpose_item(const float* W, int K, int N, bf16_t* WT, int k0, int n0, int dst_row0, LAS float* scr, int lane) {
#pragma unroll 8
    for (int i = 0; i < 32; ++i) { const int kk = 2 * i + (lane >> 5); scr[kk * 33 + (lane & 31)] = W[(size_t)(k0 + kk) * N + n0 + (lane & 31)]; }
    LDS_WAIT(); asm volatile("" ::: "memory");
    const int c = lane & 7;
#pragma unroll
    for (int j = 0; j < 4; ++j) { const int n = (lane >> 3) + 8 * j; const LAS float* s = scr + (8 * c) * 33 + n;
        u32x4 o; o.x = cvt_pk_bf16(s[0 * 33], s[1 * 33]); o.y = cvt_pk_bf16(s[2 * 33], s[3 * 33]); o.z = cvt_pk_bf16(s[4 * 33], s[5 * 33]); o.w = cvt_pk_bf16(s[6 * 33], s[7 * 33]);
        *(GAS u32x4*)(WT + (size_t)(dst_row0 + n) * K + k0 + 8 * c) = o; }
    LDS_WAIT(); asm volatile("" ::: "memory");
}
__device__ __forceinline__ void rms_row_to_bf16(int lane, const float* xrow, const float* gain, bf16_t* orow) {
    const GAS f32x4* xr = (const GAS f32x4*)xrow + lane;
    const GAS f32x4* gr = (const GAS f32x4*)gain + lane;
    f32x4 v[4]; float s = 0.f;
#pragma unroll
    for (int j = 0; j < 4; ++j) { v[j] = xr[64 * j]; s += (v[j].x * v[j].x + v[j].y * v[j].y) + (v[j].z * v[j].z + v[j].w * v[j].w); }
    const float inv = 1.0f / sqrtf(wave_sum(s) * (1.f / DM) + EPS);
    GAS u32x2* o8 = (GAS u32x2*)orow + lane;
#pragma unroll
    for (int j = 0; j < 4; ++j) { const f32x4 gg = gr[64 * j]; u32x2 w; w.x = cvt_pk_bf16(v[j].x * inv * gg.x, v[j].y * inv * gg.y); w.y = cvt_pk_bf16(v[j].z * inv * gg.z, v[j].w * inv * gg.w); o8[64 * j] = w; }
}

__device__ __forceinline__ void p0_prologue(Frame& F) {
    const int tid0 = F.ftid(), lane0 = tid0 & 63;
    LAS float* scr = (LAS float*)(F.lds + F.wave * 16384);
    const int gw = F.vcu * NWAVES + F.wave, NGW = F.G * NWAVES;
    bf16_t* win_t = (bf16_t*)(F.ws + WS_WIN); bf16_t* wout_t = (bf16_t*)(F.ws + WS_WOUT); bf16_t* wpool_t = (bf16_t*)(F.ws + WS_WPOOL);
    bf16_t* wgu_t = (bf16_t*)(F.ws + WS_WGU); bf16_t* wd_t = (bf16_t*)(F.ws + WS_WD);
    constexpr int I_IN = (DM / 64) * (NIN / 32);
    constexpr int I_OUT = (VD / 64) * (DM / 32);
    constexpr int I_POOL = 4 * (256 / 64) * (256 / 32);
    constexpr int I_GU1 = (DM / 64) * (DFF / 32);
    constexpr int I_GU = 64 * 2 * I_GU1;
    constexpr int I_D1 = (DFF / 64) * (DM / 32);
    constexpr int I_D = 64 * I_D1;
    constexpr int NITEMS = I_IN + I_OUT + I_POOL + I_GU + I_D;
    for (int it = gw; it < NITEMS; it += NGW) {
        int r = it;
        if (r < I_IN) { const int nblk = NIN / 32, kb = r / nblk, nb = r % nblk; p0_transpose_item(F.ret_w_in, DM, NIN, win_t, 64 * kb, 32 * nb, 32 * nb, scr, lane0); continue; } r -= I_IN;
        if (r < I_OUT) { const int nblk = DM / 32, kb = r / nblk, nb = r % nblk; p0_transpose_item(F.ret_w_out, VD, DM, wout_t, 64 * kb, 32 * nb, 32 * nb, scr, lane0); continue; } r -= I_OUT;
        if (r < I_POOL) { const int g = r / 32, q = r % 32, kb = q / 8, nb = q % 8; p0_transpose_item(F.pool_w + (size_t)g * 65536, 256, 256, wpool_t, 64 * kb, 32 * nb, g * 256 + 32 * nb, scr, lane0); continue; } r -= I_POOL;
        if (r < I_GU) { const int le = r / (2 * I_GU1), q = r % (2 * I_GU1), isup = q / I_GU1, q2 = q % I_GU1, kb = q2 / 8, nb = q2 % 8, n0 = 32 * nb;
            const float* W = (isup ? F.moe_w_up : F.moe_w_gate) + (size_t)le * DM * DFF;
            p0_transpose_item(W, DM, DFF, wgu_t + (size_t)le * 512 * DM, 64 * kb, n0, 256 * (n0 >> 7) + 128 * isup + (n0 & 127), scr, lane0); continue; } r -= I_GU;
        { const int le = r / I_D1, q = r % I_D1, kb = q / 32, nb = q % 32;
            p0_transpose_item(F.moe_w_down + (size_t)le * DFF * DM, DFF, DM, wd_t + (size_t)le * DM * DFF, 64 * kb, 32 * nb, 32 * nb, scr, lane0); }
    }
    { float2* tab = (float2*)(F.ws + WS_ROPE);
      for (int idx = (F.vcu * NTHREADS + tid0); idx < SEQ * 128; idx += F.G * NTHREADS) {
          const int pos = idx >> 7, i = idx & 127;
          const double inv = exp2(-(double)i * (1.0 / 128.0) * 13.287712379549449);
          const double ang = (double)pos * inv;
          double fr = ang * 0.15915494309189535; fr -= floor(fr);
          const float rr = (float)(fr * 6.283185307179586);
          float s, c; sincosf(rr, &s, &c);
          tab[idx] = make_float2(c, s);
      } }
    { bf16_t* h0 = (bf16_t*)F.out;
      for (int m = gw; m < TOK; m += NGW) rms_row_to_bf16(lane0, F.x + (size_t)m * DM, F.norm_mix, h0 + (size_t)m * DM); }
}

typedef short s16x4 __attribute__((ext_vector_type(4)));
__device__ __forceinline__ unsigned cvtpk(float lo, float hi) { unsigned r; asm("v_cvt_pk_bf16_f32 %0, %1, %2" : "=v"(r) : "v"(lo), "v"(hi)); return r; }
__device__ __forceinline__ s16x4 tr16(LAS unsigned char* p) { return __builtin_bit_cast(s16x4, __builtin_amdgcn_ds_read_tr16_b64_v4i16((LAS s16x4*)p)); }
__device__ __forceinline__ bf16x8 cat8(s16x4 lo, s16x4 hi) { return __builtin_shufflevector(lo, hi, 0, 1, 2, 3, 4, 5, 6, 7); }
__device__ __forceinline__ void p2_retention(Frame& F) {
    constexpr int QS = 0, KS = 33792, VS_ = 67584, VDS = 76800, PS = 86016, RED = 95232, SRED = 111616;
    constexpr int QP = 528, VP = 144;
    const bf16_t* qb = (const bf16_t*)(F.ws + WS_Q); const bf16_t* kb = (const bf16_t*)(F.ws + WS_K); const bf16_t* vb = (const bf16_t*)(F.ws + WS_V);
    bf16_t* ob = (bf16_t*)F.out; float* statsP = (float*)(F.ws + WS_STATS);
    LAS unsigned char* lds = F.lds;
    const int tid = F.ftid(), lane = tid & 63, g = lane >> 4, r16 = lane & 15, q4 = r16 >> 2, p4 = lane & 3;
    const int w = F.wave, vt = w >> 1, dh = w & 1;
    const int lrow = tid >> 5, lc16 = tid & 31;
    const int vrow = tid >> 3, vc16 = tid & 7;
    for (int item = F.vcu; item < BATCH * NH * 8; item += F.G) {
        const int bh = item >> 3, slice = item & 7, b = bh >> 2, h = bh & 3;
        const float lg = logf(1.0f - exp2f(-5.0f - (float)h));
        const float cd = expf(lg * 64.0f);
        const float kdv = expf(lg * (float)(63 - vrow));
        float dec[2][4], qd[4];
#pragma unroll
        for (int kk = 0; kk < 2; ++kk)
#pragma unroll
            for (int r = 0; r < 4; ++r) { const int q = 16 * vt + r16, key = 16 * (2 * dh + kk) + 4 * g + r; const int d = q > key ? q - key : key - q; dec[kk][r] = expf(lg * (float)d); }
#pragma unroll
        for (int qt = 0; qt < 4; ++qt) qd[qt] = expf(lg * (float)(16 * qt + r16 + 1));
        f32x4 st[8];
#pragma unroll
        for (int i = 0; i < 8; ++i) st[i] = (f32x4){0.f, 0.f, 0.f, 0.f};
        const size_t tokb = (size_t)b * SEQ;
        const bf16_t* qsrc = qb + (tokb + lrow) * QKD + h * 256 + lc16 * 8;
        const bf16_t* ksrc = kb + (tokb + lrow) * QKD + h * 256 + lc16 * 8;
        const bf16_t* vsrc = vb + (tokb + vrow) * VD + h * 512 + slice * 64 + vc16 * 8;
        u32x4 qn[4], kn[4], vn;
#pragma unroll
        for (int p = 0; p < 4; ++p) { qn[p] = *(const u32x4*)(qsrc + (size_t)(16 * p) * QKD); kn[p] = *(const u32x4*)(ksrc + (size_t)(16 * p) * QKD); }
        vn = *(const u32x4*)vsrc;
        __syncthreads();
#pragma unroll 1
        for (int n = 0; n < NCHUNK; ++n) {
#pragma unroll
            for (int p = 0; p < 4; ++p) { *(LAS u32x4*)(lds + QS + (lrow + 16 * p) * QP + lc16 * 16) = qn[p]; *(LAS u32x4*)(lds + KS + (lrow + 16 * p) * QP + lc16 * 16) = kn[p]; }
            { *(LAS u32x4*)(lds + VS_ + vrow * VP + vc16 * 16) = vn;
              u32x4 vd; vd.x = cvtpk(bflo(vn.x) * kdv, bfhi(vn.x) * kdv); vd.y = cvtpk(bflo(vn.y) * kdv, bfhi(vn.y) * kdv); vd.z = cvtpk(bflo(vn.z) * kdv, bfhi(vn.z) * kdv); vd.w = cvtpk(bflo(vn.w) * kdv, bfhi(vn.w) * kdv);
              *(LAS u32x4*)(lds + VDS + vrow * VP + vc16 * 16) = vd; }
            __syncthreads();
            if (n > 0 && tid < 64) {
                const LAS float* sr = (const LAS float*)(lds + SRED);
                const float s1 = (sr[(0 * 64 + tid) * 2] + sr[(1 * 64 + tid) * 2]) + (sr[(2 * 64 + tid) * 2] + sr[(3 * 64 + tid) * 2]);
                const float s2 = (sr[(0 * 64 + tid) * 2 + 1] + sr[(1 * 64 + tid) * 2 + 1]) + (sr[(2 * 64 + tid) * 2 + 1] + sr[(3 * 64 + tid) * 2 + 1]);
                *(f32x2*)(statsP + ((tokb + (size_t)(n - 1) * CHUNK + tid) * NH + h) * 16 + slice * 2) = (f32x2){s1, s2};
            }
            if (n + 1 < NCHUNK) {
                const size_t adv = (size_t)(n + 1) * CHUNK;
#pragma unroll
                for (int p = 0; p < 4; ++p) { qn[p] = *(const u32x4*)(qsrc + (adv + 16 * p) * QKD); kn[p] = *(const u32x4*)(ksrc + (adv + 16 * p) * QKD); }
                vn = *(const u32x4*)(vsrc + adv * VD);
            }
            {
                f32x4 sacc[2] = {(f32x4){0.f, 0.f, 0.f, 0.f}, (f32x4){0.f, 0.f, 0.f, 0.f}};
#pragma unroll
                for (int ks = 0; ks < 8; ++ks) {
                    const bf16x8 bq = *(const LAS bf16x8*)(lds + QS + (16 * vt + r16) * QP + (32 * ks + 8 * g) * 2);
#pragma unroll
                    for (int kk = 0; kk < 2; ++kk) {
                        const bf16x8 ak = *(const LAS bf16x8*)(lds + KS + (16 * (2 * dh + kk) + r16) * QP + (32 * ks + 8 * g) * 2);
                        sacc[kk] = __builtin_amdgcn_mfma_f32_16x16x32_bf16(ak, bq, sacc[kk], 0, 0, 0);
                    }
                }
#pragma unroll
                for (int kk = 0; kk < 2; ++kk) {
                    u32x2 pk; pk.x = cvtpk(sacc[kk][0] * dec[kk][0], sacc[kk][1] * dec[kk][1]); pk.y = cvtpk(sacc[kk][2] * dec[kk][2], sacc[kk][3] * dec[kk][3]);
                    *(LAS u32x2*)(lds + PS + (16 * vt + r16) * VP + (16 * (2 * dh + kk) + 4 * g) * 2) = pk;
                }
            }
            __syncthreads();
            f32x4 part[4];
            {
                bf16x8 afr[4];
#pragma unroll
                for (int s = 0; s < 4; ++s) { u32x4 t; t.x = cvtpk(st[2 * s][0], st[2 * s][1]); t.y = cvtpk(st[2 * s][2], st[2 * s][3]); t.z = cvtpk(st[2 * s + 1][0], st[2 * s + 1][1]); t.w = cvtpk(st[2 * s + 1][2], st[2 * s + 1][3]); afr[s] = __builtin_bit_cast(bf16x8, t); }
#pragma unroll
                for (int qt = 0; qt < 4; ++qt) {
                    f32x4 cr = (f32x4){0.f, 0.f, 0.f, 0.f};
#pragma unroll
                    for (int s = 0; s < 4; ++s) {
                        LAS unsigned char* qp = lds + QS + (16 * qt + r16) * QP + (128 * dh + 32 * s + 4 * g) * 2;
                        const s16x4 lo = *(const LAS s16x4*)(qp), hi = *(const LAS s16x4*)(qp + 32);
                        cr = __builtin_amdgcn_mfma_f32_16x16x32_bf16(afr[s], cat8(lo, hi), cr, 0, 0, 0);
                    }
                    part[qt] = cr * qd[qt];
                }
                f32x4 ia[2] = {(f32x4){0.f, 0.f, 0.f, 0.f}, (f32x4){0.f, 0.f, 0.f, 0.f}};
#pragma unroll
                for (int ks = 0; ks < 2; ++ks) {
                    LAS unsigned char* vp = lds + VS_ + (32 * ks + 8 * g + q4) * VP + (16 * vt + 4 * p4) * 2;
                    const bf16x8 av = cat8(tr16(vp), tr16(vp + 4 * VP));
#pragma unroll
                    for (int j = 0; j < 2; ++j) {
                        const bf16x8 bp = *(const LAS bf16x8*)(lds + PS + (16 * (2 * dh + j) + r16) * VP + (32 * ks + 8 * g) * 2);
                        ia[j] = __builtin_amdgcn_mfma_f32_16x16x32_bf16(av, bp, ia[j], 0, 0, 0);
                    }
                }
                if (dh == 0) { part[0] += ia[0]; part[1] += ia[1]; } else { part[2] += ia[0]; part[3] += ia[1]; }
            }
            if (dh == 1) {
#pragma unroll
                for (int qt = 0; qt < 4; ++qt) *(LAS f32x4*)(lds + RED + vt * 4096 + (qt * 64 + lane) * 16) = part[qt];
            }
            {
                bf16x8 bfr[2];
#pragma unroll
                for (int ks = 0; ks < 2; ++ks) { LAS unsigned char* vp = lds + VDS + (32 * ks + 8 * g + q4) * VP + (16 * vt + 4 * p4) * 2; bfr[ks] = cat8(tr16(vp), tr16(vp + 4 * VP)); }
#pragma unroll
                for (int i = 0; i < 8; ++i) {
                    f32x4 acc = st[i] * cd;
#pragma unroll
                    for (int ks = 0; ks < 2; ++ks) {
                        LAS unsigned char* kp = lds + KS + (32 * ks + 8 * g + q4) * QP + (128 * dh + 16 * i + 4 * p4) * 2;
                        acc = __builtin_amdgcn_mfma_f32_16x16x32_bf16(cat8(tr16(kp), tr16(kp + 4 * QP)), bfr[ks], acc, 0, 0, 0);
                    }
                    st[i] = acc;
                }
            }
            __syncthreads();
            if (dh == 0) {
                const size_t tok0 = tokb + (size_t)n * CHUNK;
#pragma unroll
                for (int qt = 0; qt < 4; ++qt) {
                    const f32x4 o = part[qt] + *(const LAS f32x4*)(lds + RED + vt * 4096 + (qt * 64 + lane) * 16);
                    u32x2 pk; pk.x = cvtpk(o[0], o[1]); pk.y = cvtpk(o[2], o[3]);
                    *(u32x2*)(ob + (tok0 + 16 * qt + r16) * VD + h * 512 + slice * 64 + 16 * vt + 4 * g) = pk;
                    float s1 = (o[0] + o[1]) + (o[2] + o[3]), s2 = (o[0] * o[0] + o[1] * o[1]) + (o[2] * o[2] + o[3] * o[3]);
                    s1 += __shfl_xor(s1, 16); s1 += __shfl_xor(s1, 32); s2 += __shfl_xor(s2, 16); s2 += __shfl_xor(s2, 32);
                    if (g == 0) *(LAS f32x2*)(lds + SRED + ((vt * 64 + 16 * qt + r16) * 2) * 4) = (f32x2){s1, s2};
                }
            }
        }
        __syncthreads();
        if (tid < 64) {
            const LAS float* sr = (const LAS float*)(lds + SRED);
            const float s1 = (sr[(0 * 64 + tid) * 2] + sr[(1 * 64 + tid) * 2]) + (sr[(2 * 64 + tid) * 2] + sr[(3 * 64 + tid) * 2]);
            const float s2 = (sr[(0 * 64 + tid) * 2 + 1] + sr[(1 * 64 + tid) * 2 + 1]) + (sr[(2 * 64 + tid) * 2 + 1] + sr[(3 * 64 + tid) * 2 + 1]);
            *(f32x2*)(statsP + ((tokb + (size_t)(NCHUNK - 1) * CHUNK + tid) * NH + h) * 16 + slice * 2) = (f32x2){s1, s2};
        }
        __syncthreads();
    }
}

__device__ __forceinline__ void p3_gating(Frame& F) {
    bf16_t* ob = (bf16_t*)F.out; const bf16_t* gb = (const bf16_t*)(F.ws + WS_G); const float* stats = (const float*)(F.ws + WS_STATS);
    const int lane3 = F.ftid() & 63;
    const int gw = F.vcu * NWAVES + F.wave, NGW = F.G * NWAVES;
    for (int m = gw; m < TOK; m += NGW) {
        float sv = stats[(size_t)m * 64 + lane3];
        sv += __shfl_xor(sv, 2); sv += __shfl_xor(sv, 4); sv += __shfl_xor(sv, 8);
#pragma unroll
        for (int j = 0; j < 4; ++j) {
            const float s1 = __shfl(sv, j * 16), s2 = __shfl(sv, j * 16 + 1);
            const float mu = s1 * (1.f / DV); const float var = fmaxf(s2 * (1.f / DV) - mu * mu, 0.f); const float rstd = 1.0f / sqrtf(var + EPS);
            u32x4* op = (u32x4*)(ob + (size_t)m * VD + j * 512) + lane3; const u32x4 ov = *op; const u32x4 gv = *((const u32x4*)(gb + (size_t)m * VD + j * 512) + lane3);
            u32x4 r;
            r.x = cvt_pk_bf16(silu_f(bflo(gv.x)) * (bflo(ov.x) - mu) * rstd, silu_f(bfhi(gv.x)) * (bfhi(ov.x) - mu) * rstd);
            r.y = cvt_pk_bf16(silu_f(bflo(gv.y)) * (bflo(ov.y) - mu) * rstd, silu_f(bfhi(gv.y)) * (bfhi(ov.y) - mu) * rstd);
            r.z = cvt_pk_bf16(silu_f(bflo(gv.z)) * (bflo(ov.z) - mu) * rstd, silu_f(bfhi(gv.z)) * (bfhi(ov.z) - mu) * rstd);
            r.w = cvt_pk_bf16(silu_f(bflo(gv.w)) * (bflo(ov.w) - mu) * rstd, silu_f(bfhi(gv.w)) * (bfhi(ov.w) - mu) * rstd);
            *op = r;
        }
    }
}

__device__ __forceinline__ void p_router(Frame& F, const float* xs, const float* gain, const float* wg, const float* bg, const float* we, const float* be, int layer) {
    LAS f32x4* wgL = (LAS f32x4*)(F.lds);
    LAS f32x4* weL = (LAS f32x4*)(F.lds + 16384);
    LAS int* list = (LAS int*)(F.lds + LDS_RT_LIST);
    LAS int* lcnt = (LAS int*)(F.lds + LDS_RT_CNT);
    bf16_t* hb = (bf16_t*)(F.ws + WS_H); int* slot_tok = (int*)(F.ws + WS_SLOT_TOK); float* slot_w = (float*)(F.ws + WS_SLOT_W);
    unsigned* cntg = F.ctl + CW_CNT + layer * 32 * 64;
    const int tid = F.ftid(); const int lane = tid & 63;
    __syncthreads();
    for (int k = tid; k < DM; k += NTHREADS) { const int sl = ((k >> 8) * 4 + (k & 3)) * 64 + ((k >> 2) & 63);
        wgL[sl] = *(const f32x4*)(wg + (size_t)k * 4);
#pragma unroll
        for (int g = 0; g < 4; ++g) { weL[(g * 2 + 0) * 1024 + sl] = *(const f32x4*)(we + (size_t)k * 32 + g * 8); weL[(g * 2 + 1) * 1024 + sl] = *(const f32x4*)(we + (size_t)k * 32 + g * 8 + 4); } }
    if (tid < 64) lcnt[tid] = 0;
    __syncthreads();
    const float bg0 = bg[0], bg1 = bg[1], bg2 = bg[2], bg3 = bg[3];
    const int rows_per_blk = TOK / F.G;
    const int row_base = F.vcu * rows_per_blk;
    for (int rr = F.wave; rr < rows_per_blk; rr += NWAVES) {
        const int m = row_base + rr;
        const GAS f32x4* xr = (const GAS f32x4*)(xs + (size_t)m * DM) + lane; const GAS f32x4* gr = (const GAS f32x4*)gain + lane;
        f32x4 v[4]; float s = 0.f;
#pragma unroll
        for (int j = 0; j < 4; ++j) { v[j] = xr[64 * j]; s += (v[j].x * v[j].x + v[j].y * v[j].y) + (v[j].z * v[j].z + v[j].w * v[j].w); }
        const float inv = 1.0f / sqrtf(wave_sum(s) * (1.f / DM) + EPS);
        GAS u32x2* o8 = (GAS u32x2*)(hb + (size_t)m * DM) + lane;
        f32x4 gl = (f32x4){0.f, 0.f, 0.f, 0.f};
#pragma unroll
        for (int j = 0; j < 4; ++j) { const f32x4 gg = gr[64 * j]; v[j].x = v[j].x * inv * gg.x; v[j].y = v[j].y * inv * gg.y; v[j].z = v[j].z * inv * gg.z; v[j].w = v[j].w * inv * gg.w;
            u32x2 w; w.x = cvt_pk_bf16(v[j].x, v[j].y); w.y = cvt_pk_bf16(v[j].z, v[j].w); o8[64 * j] = w;
            gl += wgL[(j * 4 + 0) * 64 + lane] * v[j].x; gl += wgL[(j * 4 + 1) * 64 + lane] * v[j].y; gl += wgL[(j * 4 + 2) * 64 + lane] * v[j].z; gl += wgL[(j * 4 + 3) * 64 + lane] * v[j].w; }
        float l0 = wave_sum(gl.x) + bg0, l1 = wave_sum(gl.y) + bg1, l2 = wave_sum(gl.z) + bg2, l3 = wave_sum(gl.w) + bg3;
        int grp = 0; float lm = l0;
        if (l1 > lm) { lm = l1; grp = 1; } if (l2 > lm) { lm = l2; grp = 2; } if (l3 > lm) { lm = l3; grp = 3; }
        const float ggate = 1.0f / (expf(l0 - lm) + expf(l1 - lm) + expf(l2 - lm) + expf(l3 - lm));
        f32x4 ea = (f32x4){0.f, 0.f, 0.f, 0.f}, eb = (f32x4){0.f, 0.f, 0.f, 0.f};
        const LAS f32x4* wa = weL + (grp * 2 + 0) * 1024; const LAS f32x4* wb = weL + (grp * 2 + 1) * 1024;
#pragma unroll
        for (int j = 0; j < 4; ++j) {
            ea += wa[(j * 4 + 0) * 64 + lane] * v[j].x; eb += wb[(j * 4 + 0) * 64 + lane] * v[j].x;
            ea += wa[(j * 4 + 1) * 64 + lane] * v[j].y; eb += wb[(j * 4 + 1) * 64 + lane] * v[j].y;
            ea += wa[(j * 4 + 2) * 64 + lane] * v[j].z; eb += wb[(j * 4 + 2) * 64 + lane] * v[j].z;
            ea += wa[(j * 4 + 3) * 64 + lane] * v[j].w; eb += wb[(j * 4 + 3) * 64 + lane] * v[j].w; }
        float el[8];
        el[0] = wave_sum(ea.x) + be[grp * 8 + 0]; el[1] = wave_sum(ea.y) + be[grp * 8 + 1]; el[2] = wave_sum(ea.z) + be[grp * 8 + 2]; el[3] = wave_sum(ea.w) + be[grp * 8 + 3];
        el[4] = wave_sum(eb.x) + be[grp * 8 + 4]; el[5] = wave_sum(eb.y) + be[grp * 8 + 5]; el[6] = wave_sum(eb.z) + be[grp * 8 + 6]; el[7] = wave_sum(eb.w) + be[grp * 8 + 7];
        int i1 = 0; float m1 = el[0];
#pragma unroll
        for (int i = 1; i < 8; ++i) if (el[i] > m1) { m1 = el[i]; i1 = i; }
        int i2 = -1; float m2 = -3.0e38f;
#pragma unroll
        for (int i = 0; i < 8; ++i) if (i != i1 && el[i] > m2) { m2 = el[i]; i2 = i; }
        const float r = expf(m2 - m1); const float w1 = ggate / (1.0f + r), w2 = ggate * r / (1.0f + r);
        if (lane == 0) {
            const int e1 = grp * 8 + i1, e2 = grp * 8 + i2;
            const int r1 = __hip_atomic_fetch_add(&lcnt[e1], 1, __ATOMIC_RELAXED, __HIP_MEMORY_SCOPE_WORKGROUP), r2 = __hip_atomic_fetch_add(&lcnt[e2], 1, __ATOMIC_RELAXED, __HIP_MEMORY_SCOPE_WORKGROUP);
            list[(rr * 2 + 0) * 4 + 0] = m * 2 + 0; list[(rr * 2 + 0) * 4 + 1] = e1; list[(rr * 2 + 0) * 4 + 2] = __float_as_int(w1); list[(rr * 2 + 0) * 4 + 3] = r1;
            list[(rr * 2 + 1) * 4 + 0] = m * 2 + 1; list[(rr * 2 + 1) * 4 + 1] = e2; list[(rr * 2 + 1) * 4 + 2] = __float_as_int(w2); list[(rr * 2 + 1) * 4 + 3] = r2;
        }
    }
    __syncthreads();
    if (tid < 32) { const int c = lcnt[tid]; lcnt[32 + tid] = c > 0 ? (int)__hip_atomic_fetch_add(cntg + tid * 64, (unsigned)c, RLX_AGENT) : 0; }
    __syncthreads();
    for (int i = tid; i < rows_per_blk * 2; i += NTHREADS) {
        const int p = list[i * 4 + 0], e = list[i * 4 + 1], wbits = list[i * 4 + 2], lr = list[i * 4 + 3];
        const int slot = lcnt[32 + e] + lr;
        slot_tok[(size_t)e * TOK + slot] = p; slot_w[(size_t)e * TOK + slot] = __int_as_float(wbits);
    }
}

__device__ __forceinline__ pg8::MoeTab moe_tables(Frame& F, int layer) {
    LAS int* cnt = (LAS int*)(F.lds + LDS_MOE_TAB); LAS int* ts = cnt + 32;
    const int tid = F.ftid();
    __syncthreads();
    if (tid < 32) cnt[tid] = (int)__hip_atomic_load(F.ctl + CW_CNT + (layer * 32 + tid) * 64, RLX_AGENT);
    __syncthreads();
    if (tid == 0) { int a = 0; for (int e = 0; e < 32; ++e) { ts[e] = a; a += (cnt[e] + 255) >> 8; } ts[32] = a; }
    __syncthreads();
    pg8::MoeTab T; T.cnt = cnt; T.tstart = ts; return T;
}

template <bool FINAL>
__device__ __forceinline__ void p_combine(Frame& F, float* xs, const float* gain, float* outp) {
    const bf16_t* y0 = (const bf16_t*)(F.ws + WS_Y); const bf16_t* y1 = y0 + (size_t)TOK * DM; bf16_t* hb = (bf16_t*)(F.ws + WS_H);
    const int lane = F.ftid() & 63;
    const int gw = F.vcu * NWAVES + F.wave, NGW = F.G * NWAVES;
    for (int m = gw; m < TOK; m += NGW) {
        GAS f32x4* xr = (GAS f32x4*)(xs + (size_t)m * DM) + lane; const GAS f32x4* gr = (const GAS f32x4*)gain + lane;
        const GAS u32x2* a0 = (const GAS u32x2*)(y0 + (size_t)m * DM) + lane; const GAS u32x2* a1 = (const GAS u32x2*)(y1 + (size_t)m * DM) + lane;
        f32x4 v[4]; float s = 0.f;
#pragma unroll
        for (int j = 0; j < 4; ++j) { v[j] = xr[64 * j]; const u32x2 p0 = a0[64 * j], p1 = a1[64 * j];
            v[j].x += bflo(p0.x) + bflo(p1.x); v[j].y += bfhi(p0.x) + bfhi(p1.x); v[j].z += bflo(p0.y) + bflo(p1.y); v[j].w += bfhi(p0.y) + bfhi(p1.y);
            s += (v[j].x * v[j].x + v[j].y * v[j].y) + (v[j].z * v[j].z + v[j].w * v[j].w); }
        const float inv = 1.0f / sqrtf(wave_sum(s) * (1.f / DM) + EPS);
        if constexpr (FINAL) {
            GAS f32x4* op = (GAS f32x4*)(outp + (size_t)m * DM) + lane;
#pragma unroll
            for (int j = 0; j < 4; ++j) { const f32x4 gg = gr[64 * j]; op[64 * j] = (f32x4){v[j].x * inv * gg.x, v[j].y * inv * gg.y, v[j].z * inv * gg.z, v[j].w * inv * gg.w}; }
        } else {
            GAS u32x2* o8 = (GAS u32x2*)(hb + (size_t)m * DM) + lane;
#pragma unroll
            for (int j = 0; j < 4; ++j) { xr[64 * j] = v[j]; const f32x4 gg = gr[64 * j]; u32x2 w; w.x = cvt_pk_bf16(v[j].x * inv * gg.x, v[j].y * inv * gg.y); w.y = cvt_pk_bf16(v[j].z * inv * gg.z, v[j].w * inv * gg.w); o8[64 * j] = w; }
        }
    }
}

__device__ __forceinline__ void p_pool(Frame& F) {
    const bf16_t* hb = (const bf16_t*)(F.ws + WS_H); bf16_t* pb = (bf16_t*)(F.ws + WS_POOLED);
    const int tidp = F.ftid();
    const int c0 = tidp * 2; const int w = 2 << (c0 >> 8);
    for (int tile = F.vcu; tile < TOK / 64; tile += F.G) {
        const int t0 = tile * 64; const int pos0 = t0 & (SEQ - 1);
        float s0 = 0.f, s1 = 0.f;
        for (int d = 1; d <= w; ++d) if (pos0 - d >= 0) { const unsigned u = *(const unsigned*)(hb + (size_t)(t0 - d) * DM + c0); s0 += bflo(u); s1 += bfhi(u); }
        for (int i = 0; i < 64; ++i) {
            const int pos = pos0 + i; const unsigned u = *(const unsigned*)(hb + (size_t)(t0 + i) * DM + c0);
            const float h0 = bflo(u), h1 = bfhi(u); s0 += h0; s1 += h1;
            if (pos - w >= 0) { const unsigned uo = *(const unsigned*)(hb + (size_t)(t0 + i - w) * DM + c0); s0 -= bflo(uo); s1 -= bfhi(uo); }
            const float rc = 1.0f / (float)(pos + 1 < w ? pos + 1 : w);
            *(unsigned*)(pb + (size_t)(t0 + i) * DM + c0) = cvt_pk_bf16(s0 * rc - h0, s1 * rc - h1);
        }
    }
}

struct Args { const float* in[15]; float* out; unsigned char* ws; int ph_lo, ph_hi; };
constexpr int N_PHASES = 15;

__global__ void __launch_bounds__(NTHREADS, 2) mk_fwd(Args args) {
    extern __shared__ __attribute__((aligned(16))) unsigned char lds_raw[];
    Frame F;
    F.lds = (LAS unsigned char*)lds_raw;
    F.MISC = (volatile LAS unsigned*)(F.lds + MISC_OFF);
    F.wave = __builtin_amdgcn_readfirstlane(threadIdx.x >> 6);
    F.G = gridDim.x; { const int bx = blockIdx.x; F.vcu = (F.G % 8 == 0) ? (bx % 8) * (F.G / 8) + bx / 8 : bx; }
    F.ws = args.ws; F.out = args.out; F.ctl = (unsigned*)(args.ws + WS_CTL);
    F.x = args.in[0]; F.norm_mix = args.in[1]; F.norm_ffn = args.in[2]; F.ret_w_in = args.in[3]; F.ret_w_out = args.in[4]; F.pool_w = args.in[5]; F.pool_scale = args.in[6];
    F.moe_w_group = args.in[7]; F.moe_b_group = args.in[8]; F.moe_w_expert = args.in[9]; F.moe_b_expert = args.in[10]; F.moe_w_gate = args.in[11]; F.moe_w_up = args.in[12]; F.moe_w_down = args.in[13]; F.final_norm = args.in[14];
    for (int u = threadIdx.x; u < (LDS_BYTES - LDSCTL_OFF) / 4; u += NTHREADS) ((LAS unsigned*)(F.lds + LDSCTL_OFF))[u] = 0u;
    __syncthreads();
    XcdBarrier bar; bar.bar = (unsigned*)(F.ctl + CW_BAR); bar.x = 0; bar.st = nullptr;
#if !MK_PER_PHASE
    bar = xcd_barrier_post((unsigned*)(F.ctl + CW_BAR), F.MISC + 8);
#endif
    const int lo = args.ph_lo, hi = args.ph_hi;
#ifndef PH_MASK
#define PH_MASK 0x7fff
#endif
#define IN(k) (((PH_MASK >> (k)) & 1) && lo <= (k) && (k) < hi)
#define SEAM(k) do { if (IN(k) && IN((k) + 1)) xcd_barrier(bar); } while (0)
    float* x1 = (float*)(F.ws + WS_X1);
    bf16_t* hbuf = (bf16_t*)(F.ws + WS_H);

    if (IN(0)) { p0_prologue(F); } SEAM(0);

    if (IN(1)) {
        pg8::DenseSched S; S.init((const bf16_t*)F.out, (const bf16_t*)(F.ws + WS_WIN), DM, DM, 0, TOK, NIN, F.G, (int)blockIdx.x);
        pg8::EpiQKVG E{(bf16_t*)(F.ws + WS_Q), (bf16_t*)(F.ws + WS_K), (bf16_t*)(F.ws + WS_V), (bf16_t*)(F.ws + WS_G), (const float*)(F.ws + WS_ROPE)};
        pg8::gemm_phase<pg8::EpiQKVG, pg8::DenseSched, true>(F.lds, DM, S, E);
    } SEAM(1);

    if (IN(2)) {
        p2_retention(F);
    } SEAM(2);

    if (IN(3)) { p3_gating(F); } SEAM(3);

    if (IN(4)) {
        pg8::DenseSched S; S.init((const bf16_t*)F.out, (const bf16_t*)(F.ws + WS_WOUT), VD, VD, 0, TOK, DM, F.G, (int)blockIdx.x);
        pg8::EpiResid E{F.x, x1, nullptr};
        pg8::gemm_phase<pg8::EpiResid, pg8::DenseSched, true>(F.lds, VD, S, E);
    } SEAM(4);

#define MOE_LAYER(layer, pb) do { \
        if (IN(pb)) { \
            p_router(F, x1, F.norm_ffn + (layer) * DM, F.moe_w_group + (size_t)(layer) * DM * 4, F.moe_b_group + (layer) * 4, F.moe_w_expert + (size_t)(layer) * DM * 32, F.moe_b_expert + (layer) * 32, (layer)); \
        } SEAM(pb); \
        if (IN((pb) + 1)) { \
            const pg8::MoeTab T = moe_tables(F, (layer)); \
            pg8::EpiGateUp E{(bf16_t*)(F.ws + WS_HID)}; \
            for (int i = 0;; ++i) { \
                pg8::MoeGuSched S; S.H = hbuf; S.W = (const bf16_t*)(F.ws + WS_WGU) + (size_t)(layer) * 32 * 512 * DM; S.slot_tok = (const int*)(F.ws + WS_SLOT_TOK); S.T = T; S.L = i * F.G + F.vcu; S.lda = DM; S.ldb = DM; \
                pg8::Unit u; if (!S.next(0, u)) break; \
                pg8::gemm_phase<pg8::EpiGateUp, pg8::MoeGuSched, false>(F.lds, DM, S, E); \
            } \
        } SEAM((pb) + 1); \
        if (IN((pb) + 2)) { \
            const pg8::MoeTab T = moe_tables(F, (layer)); \
            pg8::MoeDownSched S; S.HID = (const bf16_t*)(F.ws + WS_HID); S.W = (const bf16_t*)(F.ws + WS_WD) + (size_t)(layer) * 32 * DM * DFF; S.T = T; S.G = F.G; S.c = F.vcu; S.lda = DFF; S.ldb = DFF; \
            pg8::EpiDown E{(bf16_t*)(F.ws + WS_Y), (const int*)(F.ws + WS_SLOT_TOK), (const float*)(F.ws + WS_SLOT_W), T}; \
            pg8::gemm_phase<pg8::EpiDown, pg8::MoeDownSched, true>(F.lds, DFF, S, E); \
        } SEAM((pb) + 2); \
    } while (0)

    MOE_LAYER(0, 5);
    if (IN(8)) { p_combine<false>(F, x1, F.norm_mix + DM, nullptr); } SEAM(8);
    if (IN(9)) { p_pool(F); } SEAM(9);
    if (IN(10)) {
        pg8::DenseSched S; S.init((const bf16_t*)(F.ws + WS_POOLED), (const bf16_t*)(F.ws + WS_WPOOL), DM, 256, 256, TOK, DM, F.G, (int)blockIdx.x);
        pg8::EpiResid E{x1, x1, F.pool_scale};
        pg8::gemm_phase<pg8::EpiResid, pg8::DenseSched, true>(F.lds, 256, S, E);
    } SEAM(10);
    MOE_LAYER(1, 11);
#undef MOE_LAYER
    if (IN(14)) { p_combine<true>(F, x1, F.final_norm, F.out); }
#undef IN
#undef SEAM
}

extern "C" void kernel_launch(void* const* d_in, const int* in_sizes, int n_in, void* d_out, int out_size, void* d_ws, size_t ws_size, hipStream_t stream) {
    static int grid = 0;
    if (grid == 0) {
        if (n_in != 15 || in_sizes[0] != TOK * DM || out_size != TOK * DM || ws_size < WS_END) { fprintf(stderr, "kernel_launch: unexpected shapes/workspace (n_in %d, ws %zu)\n", n_in, ws_size); grid = -1; return; }
        int dev = 0, cus = 0, per_cu = 0;
        if (hipGetDevice(&dev) != hipSuccess || hipDeviceGetAttribute(&cus, hipDeviceAttributeMultiprocessorCount, dev) != hipSuccess) { grid = -1; return; }
        if (hipFuncSetAttribute((const void*)mk_fwd, hipFuncAttributeMaxDynamicSharedMemorySize, LDS_BYTES) != hipSuccess) { fprintf(stderr, "kernel_launch: hipFuncSetAttribute failed\n"); grid = -1; return; }
        if (hipOccupancyMaxActiveBlocksPerMultiprocessor(&per_cu, (const void*)mk_fwd, NTHREADS, LDS_BYTES) != hipSuccess || per_cu < 1) { fprintf(stderr, "kernel_launch: occupancy query says %d blocks/CU\n", per_cu); grid = -1; (void)hipGetLastError(); return; }
        grid = cus;
        if (grid > 256) grid = 256;
    }
    if (grid < 0) return;
    if (hipMemsetAsync((char*)d_ws + WS_CTL, 0, CTL_ZERO_BYTES, stream) != hipSuccess) return;
    Args a{};
    for (int i = 0; i < 15; ++i) a.in[i] = (const float*)d_in[i];
    a.out = (float*)d_out; a.ws = (unsigned char*)d_ws;
#if MK_PER_PHASE
    for (int p = 0; p < N_PHASES; ++p) { a.ph_lo = p; a.ph_hi = p + 1; hipLaunchKernelGGL(mk_fwd, dim3(grid), dim3(NTHREADS), LDS_BYTES, stream, a); }
#else
    a.ph_lo = 0; a.ph_hi = N_PHASES;
    hipLaunchKernelGGL(mk_fwd, dim3(grid), dim3(NTHREADS), LDS_BYTES, stream, a);
#endif
}
```

```cpp
#include <hip/hip_runtime.h>
#include <cstdio>
#include <cstdint>

#ifndef MK_PER_PHASE
#define MK_PER_PHASE 0
#endif
#ifndef RET_NAIVE
#define RET_NAIVE 1
#endif

#define GAS __attribute__((address_space(1)))
#define LAS __attribute__((address_space(3)))
typedef unsigned short bf16_t;
typedef short bf16x8 __attribute__((ext_vector_type(8)));
typedef float f32x4 __attribute__((ext_vector_type(4)));
typedef float f32x2 __attribute__((ext_vector_type(2)));
typedef unsigned u32x4 __attribute__((ext_vector_type(4)));
typedef unsigned u32x2 __attribute__((ext_vector_type(2)));

constexpr int BATCH = 8, SEQ = 4096, DM = 1024, TOK = BATCH * SEQ;
constexpr int NH = 4, DK = 256, DV = 512, QKD = 1024, VD = 2048, NIN = 6144;
constexpr int NE = 32, EPG = 8, DFF = 256;
constexpr int CHUNK = 64, NCHUNK = SEQ / CHUNK;
constexpr float EPS = 1e-6f;
constexpr int NWAVES = 8, NTHREADS = 512;

constexpr size_t MiB = 1u << 20;
constexpr size_t WS_CTL = 0, CTL_ZERO_BYTES = 1 * MiB;
constexpr size_t WS_ROPE = 1 * MiB;
constexpr size_t WS_STATS = 503 * MiB;
constexpr size_t WS_WIN = 6 * MiB;
constexpr size_t WS_WOUT = 18 * MiB;
constexpr size_t WS_WPOOL = 22 * MiB;
constexpr size_t WS_WGU = 23 * MiB;
constexpr size_t WS_WD = 87 * MiB;
constexpr size_t WS_Q = 119 * MiB;
constexpr size_t WS_K = 183 * MiB;
constexpr size_t WS_V = 247 * MiB;
constexpr size_t WS_G = 375 * MiB;
constexpr size_t WS_X1 = 119 * MiB;
constexpr size_t WS_H = 247 * MiB;
constexpr size_t WS_HID = 311 * MiB;
constexpr size_t WS_Y = 349 * MiB;
constexpr size_t WS_POOLED = 349 * MiB;
constexpr size_t WS_SLOT_TOK = 477 * MiB;
constexpr size_t WS_SLOT_W = 481 * MiB;
constexpr size_t WS_END = 511 * MiB;
constexpr int CW_TMO = 0, CW_CODE = 1;
constexpr int CW_BAR = 4096;
constexpr int CW_CNT = 16384;

constexpr int RING_BYTES = 131072;
constexpr int LDS_MOE_TAB = 131072;
constexpr int LDS_RT_LIST = 147456;
constexpr int LDS_RT_CNT = 151552;
constexpr int LDSCTL_OFF = 151808, MISC_OFF = LDSCTL_OFF + 64;
constexpr int LDS_BYTES = 155648;

#define LDS_WAIT() asm volatile("s_waitcnt lgkmcnt(0)" ::: "memory")
#define VM_WAIT() asm volatile("s_waitcnt vmcnt(0)" ::: "memory")
#define RLX_AGENT __ATOMIC_RELAXED, __HIP_MEMORY_SCOPE_AGENT

__device__ __forceinline__ unsigned cvt_pk_bf16(float lo, float hi) { unsigned r; asm volatile("v_cvt_pk_bf16_f32 %0, %1, %2" : "=v"(r) : "v"(lo), "v"(hi)); return r; }
__device__ __forceinline__ float bf2f(unsigned short u) { return __uint_as_float(((unsigned)u) << 16); }
__device__ __forceinline__ float bflo(unsigned u) { return __uint_as_float(u << 16); }
__device__ __forceinline__ float bfhi(unsigned u) { return __uint_as_float(u & 0xffff0000u); }
__device__ __forceinline__ float wave_sum(float v) {
#pragma unroll
    for (int o = 1; o < 64; o <<= 1) v += __shfl_xor(v, o);
    return v;
}
__device__ __forceinline__ float row_sum16(float v) {
    v += __int_as_float(__builtin_amdgcn_update_dpp(0, __float_as_int(v), 0xB1, 0xf, 0xf, true));
    v += __int_as_float(__builtin_amdgcn_update_dpp(0, __float_as_int(v), 0x4E, 0xf, 0xf, true));
    v += __int_as_float(__builtin_amdgcn_update_dpp(0, __float_as_int(v), 0x124, 0xf, 0xf, true));
    v += __int_as_float(__builtin_amdgcn_update_dpp(0, __float_as_int(v), 0x128, 0xf, 0xf, true));
    return v;
}
__device__ __forceinline__ float wave_sum_u(float v) {
    v = row_sum16(v);
    const float a = __int_as_float(__builtin_amdgcn_readlane(__float_as_int(v), 0)), b = __int_as_float(__builtin_amdgcn_readlane(__float_as_int(v), 16));
    const float c = __int_as_float(__builtin_amdgcn_readlane(__float_as_int(v), 32)), d = __int_as_float(__builtin_amdgcn_readlane(__float_as_int(v), 48));
    return (a + b) + (c + d);
}
__device__ __forceinline__ float silu_f(float x) { return x / (1.0f + __expf(-x)); }

namespace pg8 {
constexpr int BM = 256, BK = 64, HALF = 128, HTB = HALF * BK * 2, STAGE_BYTES = 8 * HTB, NXCD = 8, WGM = 8;
__host__ __device__ __forceinline__ int lds_byte(int r, int c) { const int st = (r >> 4) * 2 + (c >> 5), rr = r & 15, cc = c & 31, ob = rr * 64 + cc * 2; return st * 1024 + (ob ^ (((ob >> 9) & 1) << 5)); }
__host__ __device__ __forceinline__ void stage_rc(int b, int& R, int& C) { const int st = b / 1024, sb = b % 1024, swz = sb ^ (((sb >> 9) & 1) << 5); R = (st >> 1) * 16 + swz / 64; C = (st & 1) * 32 + (swz % 64) / 2; }
__host__ __device__ __forceinline__ int perm32(int rho) { const int n = rho >> 4, i = rho & 15; return 8 * (i >> 2) + 4 * n + (i & 3); }

struct Unit { int pm, pn, e, r; };

struct DenseSched {
    static constexpr bool GATHER = false;
    const bf16_t* A; const bf16_t* Bt; int lda, ldb, a_col_stride;
    int nM, nN, nwg, G, c;
    __device__ void init(const bf16_t* A_, const bf16_t* Bt_, int lda_, int ldb_, int acs, int M, int N, int G_, int c_) {
        A = A_; Bt = Bt_; lda = lda_; ldb = ldb_; a_col_stride = acs; nM = M / BM; nN = N / BM; nwg = nM * nN; G = G_; c = c_; }
    __device__ bool next(int i, Unit& u) const {
        const long L = (long)i * G + c; if (L >= nwg) return false;
        int wgid = (int)L; { const int q = nwg / NXCD, r = nwg % NXCD, xcd = wgid % NXCD, off = wgid / NXCD; wgid = (xcd < r ? xcd * (q + 1) : r * (q + 1) + (xcd - r) * q) + off; }
        const int nig = WGM * nN, gid = wgid / nig, fm = gid * WGM, gsz = (nM - fm) < WGM ? (nM - fm) : WGM;
        u.pm = fm + ((wgid % nig) % gsz); u.pn = (wgid % nig) / gsz; u.e = 0; u.r = 0; return true;
    }
    __device__ __forceinline__ const char* a_base(const Unit& u) const { return (const char*)(A + (size_t)u.pm * BM * lda + (size_t)u.pn * a_col_stride); }
    __device__ __forceinline__ const char* b_base(const Unit& u) const { return (const char*)(Bt + (size_t)u.pn * BM * ldb); }
    __device__ __forceinline__ unsigned a_row_off(const Unit&, int) const { return 0u; }
};

struct MoeTab { const LAS int* cnt; const LAS int* tstart; };
__device__ __forceinline__ bool moe_unit(const MoeTab& T, int L, int NT, Unit& u) {
    const int total = T.tstart[32];
    if (L >= total * NT) return false;
    const int tile = L / NT; u.pn = L - tile * NT; u.pm = tile;
    int e = 0;
#pragma unroll 1
    for (int j = 1; j < 32; ++j) if (T.tstart[j] <= tile) e = j;
    u.e = e; u.r = tile - T.tstart[e]; return true;
}
struct MoeGuSched {
    static constexpr bool GATHER = true;
    const bf16_t* H; const bf16_t* W; const int* slot_tok; MoeTab T; int L;
    int lda, ldb;
    __device__ bool next(int i, Unit& u) const { if (i != 0) return false; return moe_unit(T, L, 2, u); }
    __device__ __forceinline__ const char* a_base(const Unit&) const { return (const char*)H; }
    __device__ __forceinline__ const char* b_base(const Unit& u) const { return (const char*)(W + ((size_t)u.e * 512 + (size_t)u.pn * 256) * 1024); }
    __device__ __forceinline__ unsigned a_row_off(const Unit& u, int row) const {
        const int slot = u.r * 256 + row; int tok = 0;
        if (slot < T.cnt[u.e]) tok = slot_tok[(size_t)u.e * TOK + slot] >> 1;
        return (unsigned)tok * (unsigned)(DM * 2);
    }
};
struct MoeDownSched {
    static constexpr bool GATHER = false;
    const bf16_t* HID; const bf16_t* W; MoeTab T; int G, c;
    int lda, ldb;
    __device__ bool next(int i, Unit& u) const { return moe_unit(T, i * G + c, 4, u); }
    __device__ __forceinline__ const char* a_base(const Unit& u) const { return (const char*)(HID + (size_t)u.pm * 256 * DFF); }
    __device__ __forceinline__ const char* b_base(const Unit& u) const { return (const char*)(W + ((size_t)u.e * 1024 + (size_t)u.pn * 256) * DFF); }
    __device__ __forceinline__ unsigned a_row_off(const Unit&, int) const { return 0u; }
};


struct EpiQKVG {
    static constexpr bool PERM = true;
    bf16_t *q, *k, *v, *g; const float* rope;
    __device__ __forceinline__ void operator()(const f32x4 (&acc)[2][2][4][2], const Unit& u, int wr, int wc, int fr_in, int fq_in) const {
        int fr = fr_in, fq = fq_in; asm volatile("" : "+v"(fr), "+v"(fq));
        const int pn = u.pn, row0 = u.pm * BM + wr * 64 + fr, cl = wc * 32 + 8 * fq;
        if (pn < 8) {
            bf16_t* dst = (pn < 4 ? q : k) + (size_t)(pn & 3) * 256 + cl;
            const float sc = pn < 4 ? 1.0f : 0.0625f;
#pragma unroll
            for (int ai = 0; ai < 2; ++ai)
#pragma unroll
                for (int m = 0; m < 4; ++m) {
                    const int row = row0 + ai * HALF + m * 16, pos = row & (SEQ - 1);
                    const f32x4* tp = (const f32x4*)(rope + ((size_t)pos * 128 + cl) * 2);
                    const f32x4 t0 = tp[0], t1 = tp[1], t2 = tp[2], t3 = tp[3];
                    const f32x4 a0 = acc[ai][0][m][0], a1 = acc[ai][0][m][1], b0 = acc[ai][1][m][0], b1 = acc[ai][1][m][1];
                    float o1[8], o2[8];
                    o1[0] = a0[0] * t0[0] - b0[0] * t0[1]; o2[0] = a0[0] * t0[1] + b0[0] * t0[0];
                    o1[1] = a0[1] * t0[2] - b0[1] * t0[3]; o2[1] = a0[1] * t0[3] + b0[1] * t0[2];
                    o1[2] = a0[2] * t1[0] - b0[2] * t1[1]; o2[2] = a0[2] * t1[1] + b0[2] * t1[0];
                    o1[3] = a0[3] * t1[2] - b0[3] * t1[3]; o2[3] = a0[3] * t1[3] + b0[3] * t1[2];
                    o1[4] = a1[0] * t2[0] - b1[0] * t2[1]; o2[4] = a1[0] * t2[1] + b1[0] * t2[0];
                    o1[5] = a1[1] * t2[2] - b1[1] * t2[3]; o2[5] = a1[1] * t2[3] + b1[1] * t2[2];
                    o1[6] = a1[2] * t3[0] - b1[2] * t3[1]; o2[6] = a1[2] * t3[1] + b1[2] * t3[0];
                    o1[7] = a1[3] * t3[2] - b1[3] * t3[3]; o2[7] = a1[3] * t3[3] + b1[3] * t3[2];
                    u32x4 w1, w2;
                    w1.x = cvt_pk_bf16(o1[0] * sc, o1[1] * sc); w1.y = cvt_pk_bf16(o1[2] * sc, o1[3] * sc); w1.z = cvt_pk_bf16(o1[4] * sc, o1[5] * sc); w1.w = cvt_pk_bf16(o1[6] * sc, o1[7] * sc);
                    w2.x = cvt_pk_bf16(o2[0] * sc, o2[1] * sc); w2.y = cvt_pk_bf16(o2[2] * sc, o2[3] * sc); w2.z = cvt_pk_bf16(o2[4] * sc, o2[5] * sc); w2.w = cvt_pk_bf16(o2[6] * sc, o2[7] * sc);
                    bf16_t* rp = dst + (size_t)row * QKD;
                    *(u32x4*)(rp) = w1; *(u32x4*)(rp + HALF) = w2;
                }
        } else {
            bf16_t* dst = (pn < 16 ? v + (size_t)(pn - 8) * 256 : g + (size_t)(pn - 16) * 256) + cl;
#pragma unroll
            for (int ai = 0; ai < 2; ++ai)
#pragma unroll
                for (int m = 0; m < 4; ++m) {
                    bf16_t* rp = dst + (size_t)(row0 + ai * HALF + m * 16) * VD;
#pragma unroll
                    for (int bj = 0; bj < 2; ++bj) { const f32x4 v0 = acc[ai][bj][m][0], v1 = acc[ai][bj][m][1];
                        u32x4 w; w.x = cvt_pk_bf16(v0[0], v0[1]); w.y = cvt_pk_bf16(v0[2], v0[3]); w.z = cvt_pk_bf16(v1[0], v1[1]); w.w = cvt_pk_bf16(v1[2], v1[3]);
                        *(u32x4*)(rp + bj * HALF) = w; }
                }
        }
    }
};
struct EpiResid {
    static constexpr bool PERM = false;
    const float* base; float* out; const float* scale;
    __device__ __forceinline__ void operator()(const f32x4 (&acc)[2][2][4][2], const Unit& u, int wr, int wc, int fr_in, int fq_in) const {
        int fr = fr_in, fq = fq_in; asm volatile("" : "+v"(fr), "+v"(fq));
        const int col0 = u.pn * BM + wc * 32 + 4 * fq;
        f32x4 sv[2][2];
#pragma unroll
        for (int bj = 0; bj < 2; ++bj)
#pragma unroll
            for (int n = 0; n < 2; ++n) sv[bj][n] = scale ? *(const f32x4*)(scale + col0 + bj * HALF + n * 16) : (f32x4){1.f, 1.f, 1.f, 1.f};
#pragma unroll
        for (int ai = 0; ai < 2; ++ai)
#pragma unroll
            for (int m = 0; m < 4; ++m) { const size_t off = (size_t)(u.pm * BM + ai * HALF + wr * 64 + m * 16 + fr) * DM + col0;
#pragma unroll
                for (int bj = 0; bj < 2; ++bj)
#pragma unroll
                    for (int n = 0; n < 2; ++n) { const f32x4 bs = *(const f32x4*)(base + off + bj * HALF + n * 16);
                        *(f32x4*)(out + off + bj * HALF + n * 16) = bs + acc[ai][bj][m][n] * sv[bj][n]; } }
    }
};
struct EpiGateUp {
    static constexpr bool PERM = true;
    bf16_t* hid;
    __device__ __forceinline__ void operator()(const f32x4 (&acc)[2][2][4][2], const Unit& u, int wr, int wc, int fr_in, int fq_in) const {
        int fr = fr_in, fq = fq_in; asm volatile("" : "+v"(fr), "+v"(fq));
        bf16_t* dst = hid + (size_t)u.pm * 256 * DFF + u.pn * 128 + wc * 32 + 8 * fq;
#pragma unroll
        for (int ai = 0; ai < 2; ++ai)
#pragma unroll
            for (int m = 0; m < 4; ++m) {
                const f32x4 g0 = acc[ai][0][m][0], g1 = acc[ai][0][m][1], u0 = acc[ai][1][m][0], u1 = acc[ai][1][m][1];
                u32x4 w;
                w.x = cvt_pk_bf16(silu_f(g0[0]) * u0[0], silu_f(g0[1]) * u0[1]); w.y = cvt_pk_bf16(silu_f(g0[2]) * u0[2], silu_f(g0[3]) * u0[3]);
                w.z = cvt_pk_bf16(silu_f(g1[0]) * u1[0], silu_f(g1[1]) * u1[1]); w.w = cvt_pk_bf16(silu_f(g1[2]) * u1[2], silu_f(g1[3]) * u1[3]);
                *(u32x4*)(dst + (size_t)(ai * HALF + wr * 64 + m * 16 + fr) * DFF) = w;
            }
    }
};
struct EpiDown {
    static constexpr bool PERM = true;
    bf16_t* y; const int* slot_tok; const float* slot_w; MoeTab T;
    __device__ __forceinline__ void operator()(const f32x4 (&acc)[2][2][4][2], const Unit& u, int wr, int wc, int fr_in, int fq_in) const {
        int fr = fr_in, fq = fq_in; asm volatile("" : "+v"(fr), "+v"(fq));
        const int cnt = T.cnt[u.e]; const int cl = u.pn * BM + wc * 32 + 8 * fq;
#pragma unroll
        for (int ai = 0; ai < 2; ++ai)
#pragma unroll
            for (int m = 0; m < 4; ++m) {
                const int slot = u.r * 256 + ai * HALF + wr * 64 + m * 16 + fr;
                if (slot < cnt) {
                    const int p = slot_tok[(size_t)u.e * TOK + slot]; const float w = slot_w[(size_t)u.e * TOK + slot];
                    bf16_t* rp = y + ((size_t)(p & 1) * TOK + (size_t)(p >> 1)) * DM + cl;
#pragma unroll
                    for (int bj = 0; bj < 2; ++bj) { const f32x4 v0 = acc[ai][bj][m][0] * w, v1 = acc[ai][bj][m][1] * w;
                        u32x4 o; o.x = cvt_pk_bf16(v0[0], v0[1]); o.y = cvt_pk_bf16(v0[2], v0[3]); o.z = cvt_pk_bf16(v1[0], v1[1]); o.w = cvt_pk_bf16(v1[2], v1[3]);
                        *(u32x4*)(rp + bj * HALF) = o; }
                }
            }
    }
};

template <class Epi, class Sched, bool ALIGN_EPI>
__device__ __forceinline__ void gemm_phase(LAS unsigned char* lds, const int K, const Sched& S, const Epi& E) {
    int tid = threadIdx.x; asm volatile("" : "+v"(tid));
    const int wid = __builtin_amdgcn_readfirstlane(tid >> 6), lane = tid & 63, wr = wid >> 2, wc = wid & 3, fr = lane & 15, fq = lane >> 4;
    const int nt = K / BK;
    const unsigned lda_b = (unsigned)S.lda * 2u, ldb_b = (unsigned)S.ldb * 2u;
    int Rs[2], Cs[2];
    unsigned voffA[2][2], voffB[2];
#pragma unroll
    for (int i = 0; i < 2; ++i) { stage_rc(tid * 16 + i * 8192, Rs[i], Cs[i]); const int Rb = Epi::PERM ? ((Rs[i] & ~31) + perm32(Rs[i] & 31)) : Rs[i];
        voffB[i] = (unsigned)Rb * ldb_b + (unsigned)Cs[i] * 2u;
        voffA[0][i] = (unsigned)Rs[i] * lda_b + (unsigned)Cs[i] * 2u; voffA[1][i] = voffA[0][i]; }
    const size_t kstep = (size_t)(BK * 2);
    const size_t hstepA = Sched::GATHER ? 0 : (size_t)HALF * lda_b;
    const size_t hstepB = (size_t)HALF * ldb_b;
    const unsigned ldsw = (unsigned)wid * 1024u;
    const int aoff = lds_byte(wr * 64 + fr, fq * 8), boff = lds_byte(wc * 32 + fr, fq * 8);
#define PG8_SA(b, h) (((b) * 2 + (h)) * HTB)
#define PG8_SB(b, h) ((4 + (b) * 2 + (h)) * HTB)
#define PG8_STAGEA(bufoff, gbase, h) do { _Pragma("unroll") for (int _i = 0; _i < 2; ++_i) \
        __builtin_amdgcn_global_load_lds((const unsigned*)((const char*)(gbase) + voffA[h][_i]), (LAS unsigned*)(lds + (bufoff) + ldsw + _i * 8192), 16, 0, 0); } while (0)
#define PG8_STAGEB(bufoff, gbase) do { _Pragma("unroll") for (int _i = 0; _i < 2; ++_i) \
        __builtin_amdgcn_global_load_lds((const unsigned*)((const char*)(gbase) + voffB[_i]), (LAS unsigned*)(lds + (bufoff) + ldsw + _i * 8192), 16, 0, 0); } while (0)
#define PG8_LDA(dst, b, h) do { _Pragma("unroll") for (int m = 0; m < 4; ++m) _Pragma("unroll") for (int k = 0; k < 2; ++k) dst[m][k] = *(const LAS bf16x8*)(lds + PG8_SA(b, h) + aoff + m * 2048 + k * 1024); } while (0)
#define PG8_LDB(dst, b, h) do { _Pragma("unroll") for (int n = 0; n < 2; ++n) _Pragma("unroll") for (int k = 0; k < 2; ++k) dst[n][k] = *(const LAS bf16x8*)(lds + PG8_SB(b, h) + boff + n * 2048 + k * 1024); } while (0)
#define PG8_MMA(ai, bj, At, Bt) do { __builtin_amdgcn_s_setprio(1); _Pragma("unroll") for (int m = 0; m < 4; ++m) _Pragma("unroll") for (int n = 0; n < 2; ++n) _Pragma("unroll") for (int k = 0; k < 2; ++k) \
        acc[ai][bj][m][n] = __builtin_amdgcn_mfma_f32_16x16x32_bf16(Bt[n][k], At[m][k], acc[ai][bj][m][n], 0, 0, 0); __builtin_amdgcn_s_setprio(0); } while (0)
#define PG8_WAIT_V(n) asm volatile("s_waitcnt vmcnt(" #n ")" ::: "memory")
#define PG8_WAIT_L(n) asm volatile("s_waitcnt lgkmcnt(" #n ")" ::: "memory")
#define PG8_BAR __builtin_amdgcn_s_barrier()
#define PG8_SCHED __builtin_amdgcn_sched_barrier(0)
    Unit cur, nxt; int ui = 0;
    if (!S.next(0, cur)) return;
    if constexpr (Sched::GATHER) {
#pragma unroll
        for (int h = 0; h < 2; ++h)
#pragma unroll
            for (int i = 0; i < 2; ++i) voffA[h][i] = S.a_row_off(cur, h * HALF + Rs[i]) + (unsigned)Cs[i] * 2u;
    }
    f32x4 acc[2][2][4][2];
#pragma unroll
    for (int a = 0; a < 2; ++a)
#pragma unroll
        for (int b = 0; b < 2; ++b)
#pragma unroll
            for (int m = 0; m < 4; ++m)
#pragma unroll
                for (int n = 0; n < 2; ++n) acc[a][b][m][n] = (f32x4){0.f, 0.f, 0.f, 0.f};
    bf16x8 At[4][2], B0[2][2], B1[2][2];
    const char* cA = S.a_base(cur); const char* cB = S.b_base(cur);
    PG8_STAGEB(PG8_SB(0, 0), cB); PG8_STAGEB(PG8_SB(0, 1), cB + hstepB); PG8_STAGEA(PG8_SA(0, 0), cA, 0); PG8_STAGEA(PG8_SA(0, 1), cA + hstepA, 1);
    if (wr == 1) PG8_BAR;
    PG8_WAIT_V(2); PG8_BAR;
    PG8_STAGEB(PG8_SB(1, 0), cB + kstep); PG8_STAGEA(PG8_SA(1, 0), cA + kstep, 0); PG8_STAGEB(PG8_SB(1, 1), cB + hstepB + kstep);
    PG8_WAIT_V(6); PG8_BAR;
    for (;;) {
        const bool has_next = Sched::GATHER ? false : S.next(ui + 1, nxt);
        const char* nA = has_next ? S.a_base(nxt) : cA; const char* nB = has_next ? S.b_base(nxt) : cB;
        for (int t = 0; t < nt; t += 2) {
            const bool last = (t == nt - 2);
            const char* a1 = cA + (size_t)(t + 1) * kstep;
            const char* a2 = last ? nA : cA + (size_t)(t + 2) * kstep; const char* b2 = last ? nB : cB + (size_t)(t + 2) * kstep;
            const char* a3 = a2 + kstep; const char* b3 = b2 + kstep;
            PG8_LDB(B0, 0, 0); PG8_LDB(B1, 0, 1); PG8_SCHED; PG8_LDA(At, 0, 0); PG8_STAGEA(PG8_SA(1, 1), a1 + hstepA, 1);
            PG8_WAIT_V(8); PG8_WAIT_L(0); PG8_BAR; PG8_MMA(0, 0, At, B0); PG8_MMA(0, 1, At, B1); PG8_BAR; PG8_SCHED;
            PG8_LDA(At, 0, 1); PG8_STAGEB(PG8_SB(0, 0), b2); PG8_STAGEB(PG8_SB(0, 1), b2 + hstepB); PG8_STAGEA(PG8_SA(0, 0), a2, 0);
            PG8_WAIT_V(8); PG8_WAIT_L(0); PG8_BAR; PG8_MMA(1, 0, At, B0); PG8_MMA(1, 1, At, B1); PG8_BAR; PG8_SCHED;
            PG8_LDB(B0, 1, 0); PG8_LDB(B1, 1, 1); PG8_SCHED; PG8_LDA(At, 1, 0); PG8_STAGEA(PG8_SA(0, 1), a2 + hstepA, 1);
            PG8_WAIT_V(8); PG8_WAIT_L(0); PG8_BAR; PG8_MMA(0, 0, At, B0); PG8_MMA(0, 1, At, B1); PG8_BAR; PG8_SCHED;
            PG8_LDA(At, 1, 1); PG8_STAGEB(PG8_SB(1, 0), b3); PG8_STAGEB(PG8_SB(1, 1), b3 + hstepB); PG8_STAGEA(PG8_SA(1, 0), a3, 0);
            PG8_WAIT_V(8); PG8_WAIT_L(0); PG8_BAR; PG8_MMA(1, 0, At, B0); PG8_MMA(1, 1, At, B1); PG8_BAR; PG8_SCHED;
        }
        if constexpr (ALIGN_EPI) { if (wr == 0) PG8_BAR; }
        E(acc, cur, wr, wc, fr, fq);
        if (!has_next) break;
#pragma unroll
        for (int a = 0; a < 2; ++a)
#pragma unroll
            for (int b = 0; b < 2; ++b)
#pragma unroll
                for (int m = 0; m < 4; ++m)
#pragma unroll
                    for (int n = 0; n < 2; ++n) acc[a][b][m][n] = (f32x4){0.f, 0.f, 0.f, 0.f};
        cur = nxt; cA = nA; cB = nB; ++ui;
        if constexpr (ALIGN_EPI) { if (wr == 1) PG8_BAR; }
    }
    PG8_WAIT_V(0);
    if constexpr (!ALIGN_EPI) { if (wr == 0) PG8_BAR; }
    PG8_BAR;
#undef PG8_SA
#undef PG8_SB
#undef PG8_STAGEA
#undef PG8_STAGEB
#undef PG8_LDA
#undef PG8_LDB
#undef PG8_MMA
#undef PG8_WAIT_V
#undef PG8_WAIT_L
#undef PG8_BAR
#undef PG8_SCHED
}
}

#define XB_TMO      128
#define XB_XCNT(j)  (256  + 64 * (j))
#define XB_XSUB(j)  (1280 + 64 * (j))
#define XB_XGEN(j)  (2304 + 64 * (j))
#define XB_TOP      3328
#define XB_TOPGEN   3392
#define XCD_BAR_WORDS 3456
#define XB_SPIN_CAP (1u << 18)
__device__ __forceinline__ unsigned xb_ld(unsigned* p)              { return __hip_atomic_load(p, __ATOMIC_RELAXED, __HIP_MEMORY_SCOPE_AGENT); }
__device__ __forceinline__ unsigned xb_add(unsigned* p, unsigned v) { return __hip_atomic_fetch_add(p, v, __ATOMIC_RELAXED, __HIP_MEMORY_SCOPE_AGENT); }
__device__ __forceinline__ unsigned xb_xcc_id() { return (unsigned)__builtin_amdgcn_s_getreg((3 << 11) | 20) & 0xFu; }
#define XB_SPIN(cond, bar) do { unsigned _sp = 0; while (cond) { __builtin_amdgcn_s_sleep(1); \
    if ((++_sp & 255u) == 0u) { if (xb_ld(&(bar)[XB_TMO])) break; if (_sp > XB_SPIN_CAP) { atomicAdd(&(bar)[XB_TMO], 1u); break; } } } } while (0)
struct XcdBarrier { unsigned* bar; unsigned x; volatile LAS unsigned* st; };
__device__ __forceinline__ XcdBarrier xcd_barrier_post(unsigned* bar, volatile LAS unsigned* st) {
    XcdBarrier b; b.bar = bar; b.x = xb_xcc_id(); b.st = st;
    if (threadIdx.x == 0) (void)xb_add(&bar[XB_XCNT(b.x)], 1u);
    return b;
}
__device__ __forceinline__ void xcd_barrier_complete(unsigned* bar, unsigned x, unsigned& nloc, unsigned& nx) {
    const unsigned G = gridDim.x * gridDim.y * gridDim.z;
    unsigned sum, cnt, mine, sp = 0u;
    for (;;) {
        sum = 0u; cnt = 0u; mine = 0u;
#pragma unroll
        for (unsigned j = 0; j < 16; ++j) { const unsigned c = xb_ld(&bar[XB_XCNT(j)]); sum += c; cnt += (c > 0u) ? 1u : 0u; mine = (j == x) ? c : mine; }
        if (sum == G) break;
        __builtin_amdgcn_s_sleep(1);
        if ((++sp & 255u) == 0u) { if (xb_ld(&bar[XB_TMO])) break; if (sp > XB_SPIN_CAP) { atomicAdd(&bar[XB_TMO], 1u); break; } }
    }
    nloc = mine > 0u ? mine : 1u; nx = cnt > 0u ? cnt : 1u;
}
__device__ __forceinline__ void xcd_barrier(const XcdBarrier& b) {
    asm volatile("s_waitcnt vmcnt(0)" ::: "memory");
    __syncthreads();
    if (threadIdx.x == 0) {
        unsigned* bar = b.bar;
        __builtin_amdgcn_s_waitcnt(0);
        unsigned nloc = b.st[0], nx = b.st[1];
        if (nloc == 0u) { xcd_barrier_complete(bar, b.x, nloc, nx); b.st[0] = nloc; b.st[1] = nx; }
        const unsigned old = xb_add(&bar[XB_XSUB(b.x)], 1u);
        const unsigned gen = old / nloc;
        if (old + 1u == (gen + 1u) * nloc) {
            __builtin_amdgcn_fence(__ATOMIC_RELEASE, "agent");
            asm volatile("s_waitcnt vmcnt(0)" ::: "memory");
            const unsigned og = xb_add(&bar[XB_TOP], 1u);
            const unsigned tg = og / nx;
            if (og + 1u == (tg + 1u) * nx) xb_add(&bar[XB_TOPGEN], 1u);
            else XB_SPIN(xb_ld(&bar[XB_TOPGEN]) == tg, bar);
            __builtin_amdgcn_fence(__ATOMIC_ACQUIRE, "agent");
            xb_add(&bar[XB_XGEN(b.x)], 1u);
            asm volatile("s_waitcnt vmcnt(0)" ::: "memory");
        } else {
            XB_SPIN(xb_ld(&bar[XB_XGEN(b.x)]) == gen, bar);
            __builtin_amdgcn_fence(__ATOMIC_ACQUIRE, "agent");
            asm volatile("s_waitcnt vmcnt(0)" ::: "memory");
        }
    }
    __syncthreads();
}

struct Frame {
    LAS unsigned char* lds;
    volatile LAS unsigned* MISC;
    unsigned* ctl;
    int wave, vcu, G;
    __device__ __forceinline__ int ftid() const { int t = threadIdx.x; asm volatile("" : "+v"(t)); return t; }
    unsigned char* ws; float* out;
    const float *x, *norm_mix, *norm_ffn, *ret_w_in, *ret_w_out, *pool_w, *pool_scale, *moe_w_group, *moe_b_group, *moe_w_expert, *moe_b_expert, *moe_w_gate, *moe_w_up, *moe_w_down, *final_norm;
};

__device__ __forceinline__ void p0_transpose_item(const float* W, int K, int N, bf16_t* WT, int k0, int n0, int dst_row0, LAS float* scr, int lane) {
#pragma unroll 8
    for (int i = 0; i < 32; ++i) { const int kk = 2 * i + (lane >> 5); scr[kk * 33 + (lane & 31)] = W[(size_t)(k0 + kk) * N + n0 + (lane & 31)]; }
    LDS_WAIT(); asm volatile("" ::: "memory");
    const int c = lane & 7;
#pragma unroll
    for (int j = 0; j < 4; ++j) { const int n = (lane >> 3) + 8 * j; const LAS float* s = scr + (8 * c) * 33 + n;
        u32x4 o; o.x = cvt_pk_bf16(s[0 * 33], s[1 * 33]); o.y = cvt_pk_bf16(s[2 * 33], s[3 * 33]); o.z = cvt_pk_bf16(s[4 * 33], s[5 * 33]); o.w = cvt_pk_bf16(s[6 * 33], s[7 * 33]);
        *(GAS u32x4*)(WT + (size_t)(dst_row0 + n) * K + k0 + 8 * c) = o; }
    LDS_WAIT(); asm volatile("" ::: "memory");
}
__device__ __forceinline__ void rms_row_to_bf16(int lane, const float* xrow, const float* gain, bf16_t* orow) {
    const GAS f32x4* xr = (const GAS f32x4*)xrow + lane;
    const GAS f32x4* gr = (const GAS f32x4*)gain + lane;
    f32x4 v[4]; float s = 0.f;
#pragma unroll
    for (int j = 0; j < 4; ++j) { v[j] = xr[64 * j]; s += (v[j].x * v[j].x + v[j].y * v[j].y) + (v[j].z * v[j].z + v[j].w * v[j].w); }
    const float inv = 1.0f / sqrtf(wave_sum(s) * (1.f / DM) + EPS);
    GAS u32x2* o8 = (GAS u32x2*)orow + lane;
#pragma unroll
    for (int j = 0; j < 4; ++j) { const f32x4 gg = gr[64 * j]; u32x2 w; w.x = cvt_pk_bf16(v[j].x * inv * gg.x, v[j].y * inv * gg.y); w.y = cvt_pk_bf16(v[j].z * inv * gg.z, v[j].w * inv * gg.w); o8[64 * j] = w; }
}

__device__ __forceinline__ void p0_prologue(Frame& F) {
    const int tid0 = F.ftid(), lane0 = tid0 & 63;
    LAS float* scr = (LAS float*)(F.lds + F.wave * 16384);
    const int gw = F.vcu * NWAVES + F.wave, NGW = F.G * NWAVES;
    bf16_t* win_t = (bf16_t*)(F.ws + WS_WIN); bf16_t* wout_t = (bf16_t*)(F.ws + WS_WOUT); bf16_t* wpool_t = (bf16_t*)(F.ws + WS_WPOOL);
    bf16_t* wgu_t = (bf16_t*)(F.ws + WS_WGU); bf16_t* wd_t = (bf16_t*)(F.ws + WS_WD);
    constexpr int I_IN = (DM / 64) * (NIN / 32);
    constexpr int I_OUT = (VD / 64) * (DM / 32);
    constexpr int I_POOL = 4 * (256 / 64) * (256 / 32);
    constexpr int I_GU1 = (DM / 64) * (DFF / 32);
    constexpr int I_GU = 64 * 2 * I_GU1;
    constexpr int I_D1 = (DFF / 64) * (DM / 32);
    constexpr int I_D = 64 * I_D1;
    constexpr int NITEMS = I_IN + I_OUT + I_POOL + I_GU + I_D;
    for (int it = gw; it < NITEMS; it += NGW) {
        int r = it;
        if (r < I_IN) { const int nblk = NIN / 32, kb = r / nblk, nb = r % nblk; p0_transpose_item(F.ret_w_in, DM, NIN, win_t, 64 * kb, 32 * nb, 32 * nb, scr, lane0); continue; } r -= I_IN;
        if (r < I_OUT) { const int nblk = DM / 32, kb = r / nblk, nb = r % nblk; p0_transpose_item(F.ret_w_out, VD, DM, wout_t, 64 * kb, 32 * nb, 32 * nb, scr, lane0); continue; } r -= I_OUT;
        if (r < I_POOL) { const int g = r / 32, q = r % 32, kb = q / 8, nb = q % 8; p0_transpose_item(F.pool_w + (size_t)g * 65536, 256, 256, wpool_t, 64 * kb, 32 * nb, g * 256 + 32 * nb, scr, lane0); continue; } r -= I_POOL;
        if (r < I_GU) { const int le = r / (2 * I_GU1), q = r % (2 * I_GU1), isup = q / I_GU1, q2 = q % I_GU1, kb = q2 / 8, nb = q2 % 8, n0 = 32 * nb;
            const float* W = (isup ? F.moe_w_up : F.moe_w_gate) + (size_t)le * DM * DFF;
            p0_transpose_item(W, DM, DFF, wgu_t + (size_t)le * 512 * DM, 64 * kb, n0, 256 * (n0 >> 7) + 128 * isup + (n0 & 127), scr, lane0); continue; } r -= I_GU;
        { const int le = r / I_D1, q = r % I_D1, kb = q / 32, nb = q % 32;
            p0_transpose_item(F.moe_w_down + (size_t)le * DFF * DM, DFF, DM, wd_t + (size_t)le * DM * DFF, 64 * kb, 32 * nb, 32 * nb, scr, lane0); }
    }
    { float2* tab = (float2*)(F.ws + WS_ROPE);
      for (int idx = (F.vcu * NTHREADS + tid0); idx < SEQ * 128; idx += F.G * NTHREADS) {
          const int pos = idx >> 7, i = idx & 127;
          const double inv = exp2(-(double)i * (1.0 / 128.0) * 13.287712379549449);
          const double ang = (double)pos * inv;
          double fr = ang * 0.15915494309189535; fr -= floor(fr);
          const float rr = (float)(fr * 6.283185307179586);
          float s, c; sincosf(rr, &s, &c);
          tab[idx] = make_float2(c, s);
      } }
    { bf16_t* h0 = (bf16_t*)F.out;
      for (int m = gw; m < TOK; m += NGW) rms_row_to_bf16(lane0, F.x + (size_t)m * DM, F.norm_mix, h0 + (size_t)m * DM); }
}

typedef short s16x4 __attribute__((ext_vector_type(4)));
__device__ __forceinline__ unsigned cvtpk(float lo, float hi) { unsigned r; asm("v_cvt_pk_bf16_f32 %0, %1, %2" : "=v"(r) : "v"(lo), "v"(hi)); return r; }
__device__ __forceinline__ s16x4 tr16(LAS unsigned char* p) { return __builtin_bit_cast(s16x4, __builtin_amdgcn_ds_read_tr16_b64_v4i16((LAS s16x4*)p)); }
__device__ __forceinline__ bf16x8 cat8(s16x4 lo, s16x4 hi) { return __builtin_shufflevector(lo, hi, 0, 1, 2, 3, 4, 5, 6, 7); }
__device__ __forceinline__ void p2_retention(Frame& F) {
    constexpr int QS = 0, KS = 33792, VS_ = 67584, VDS = 76800, PS = 86016, RED = 95232, SRED = 111616;
    constexpr int QP = 528, VP = 144;
    const bf16_t* qb = (const bf16_t*)(F.ws + WS_Q); const bf16_t* kb = (const bf16_t*)(F.ws + WS_K); const bf16_t* vb = (const bf16_t*)(F.ws + WS_V);
    bf16_t* ob = (bf16_t*)F.out; float* statsP = (float*)(F.ws + WS_STATS);
    LAS unsigned char* lds = F.lds;
    const int tid = F.ftid(), lane = tid & 63, g = lane >> 4, r16 = lane & 15, q4 = r16 >> 2, p4 = lane & 3;
    const int w = F.wave, vt = w >> 1, dh = w & 1;
    const int lrow = tid >> 5, lc16 = tid & 31;
    const int vrow = tid >> 3, vc16 = tid & 7;
    for (int item = F.vcu; item < BATCH * NH * 8; item += F.G) {
        const int bh = item >> 3, slice = item & 7, b = bh >> 2, h = bh & 3;
        const float lg = logf(1.0f - exp2f(-5.0f - (float)h));
        const float cd = expf(lg * 64.0f);
        const float kdv = expf(lg * (float)(63 - vrow));
        float dec[2][4], qd[4];
#pragma unroll
        for (int kk = 0; kk < 2; ++kk)
#pragma unroll
            for (int r = 0; r < 4; ++r) { const int q = 16 * vt + r16, key = 16 * (2 * dh + kk) + 4 * g + r; const int d = q > key ? q - key : key - q; dec[kk][r] = expf(lg * (float)d); }
#pragma unroll
        for (int qt = 0; qt < 4; ++qt) qd[qt] = expf(lg * (float)(16 * qt + r16 + 1));
        f32x4 st[8];
#pragma unroll
        for (int i = 0; i < 8; ++i) st[i] = (f32x4){0.f, 0.f, 0.f, 0.f};
        const size_t tokb = (size_t)b * SEQ;
        const bf16_t* qsrc = qb + (tokb + lrow) * QKD + h * 256 + lc16 * 8;
        const bf16_t* ksrc = kb + (tokb + lrow) * QKD + h * 256 + lc16 * 8;
        const bf16_t* vsrc = vb + (tokb + vrow) * VD + h * 512 + slice * 64 + vc16 * 8;
        u32x4 qn[4], kn[4], vn;
#pragma unroll
        for (int p = 0; p < 4; ++p) { qn[p] = *(const u32x4*)(qsrc + (size_t)(16 * p) * QKD); kn[p] = *(const u32x4*)(ksrc + (size_t)(16 * p) * QKD); }
        vn = *(const u32x4*)vsrc;
        __syncthreads();
#define P2_STAGE() do { \
            _Pragma("unroll") for (int p = 0; p < 4; ++p) { *(LAS u32x4*)(lds + QS + (lrow + 16 * p) * QP + lc16 * 16) = qn[p]; *(LAS u32x4*)(lds + KS + (lrow + 16 * p) * QP + lc16 * 16) = kn[p]; } \
            *(LAS u32x4*)(lds + VS_ + vrow * VP + vc16 * 16) = vn; \
            u32x4 vd; vd.x = cvtpk(bflo(vn.x) * kdv, bfhi(vn.x) * kdv); vd.y = cvtpk(bflo(vn.y) * kdv, bfhi(vn.y) * kdv); vd.z = cvtpk(bflo(vn.z) * kdv, bfhi(vn.z) * kdv); vd.w = cvtpk(bflo(vn.w) * kdv, bfhi(vn.w) * kdv); \
            *(LAS u32x4*)(lds + VDS + vrow * VP + vc16 * 16) = vd; } while (0)
#define P2_PREFETCH(nn) do { const size_t adv = (size_t)(nn) * CHUNK; \
            _Pragma("unroll") for (int p = 0; p < 4; ++p) { qn[p] = *(const u32x4*)(qsrc + (adv + 16 * p) * QKD); kn[p] = *(const u32x4*)(ksrc + (adv + 16 * p) * QKD); } \
            vn = *(const u32x4*)(vsrc + adv * VD); } while (0)
        P2_STAGE();
        P2_PREFETCH(1);
        __syncthreads();
#pragma unroll 1
        for (int n = 0; n < NCHUNK; ++n) {
            {
                bf16x8 bq[8], ak[2][8];
#pragma unroll
                for (int ks = 0; ks < 8; ++ks) {
                    bq[ks] = *(const LAS bf16x8*)(lds + QS + (16 * vt + r16) * QP + (32 * ks + 8 * g) * 2);
#pragma unroll
                    for (int kk = 0; kk < 2; ++kk) ak[kk][ks] = *(const LAS bf16x8*)(lds + KS + (16 * (2 * dh + kk) + r16) * QP + (32 * ks + 8 * g) * 2);
                }
                __builtin_amdgcn_sched_barrier(0);
                f32x4 sacc[2] = {(f32x4){0.f, 0.f, 0.f, 0.f}, (f32x4){0.f, 0.f, 0.f, 0.f}};
#pragma unroll
                for (int ks = 0; ks < 8; ++ks)
#pragma unroll
                    for (int kk = 0; kk < 2; ++kk) sacc[kk] = __builtin_amdgcn_mfma_f32_16x16x32_bf16(ak[kk][ks], bq[ks], sacc[kk], 0, 0, 0);
#pragma unroll
                for (int kk = 0; kk < 2; ++kk) {
                    u32x2 pk; pk.x = cvtpk(sacc[kk][0] * dec[kk][0], sacc[kk][1] * dec[kk][1]); pk.y = cvtpk(sacc[kk][2] * dec[kk][2], sacc[kk][3] * dec[kk][3]);
                    *(LAS u32x2*)(lds + PS + (16 * vt + r16) * VP + (16 * (2 * dh + kk) + 4 * g) * 2) = pk;
                }
            }
            __syncthreads();
            f32x4 part[4];
            {
                bf16x8 afr[4];
#pragma unroll
                for (int s = 0; s < 4; ++s) { u32x4 t; t.x = cvtpk(st[2 * s][0], st[2 * s][1]); t.y = cvtpk(st[2 * s][2], st[2 * s][3]); t.z = cvtpk(st[2 * s + 1][0], st[2 * s + 1][1]); t.w = cvtpk(st[2 * s + 1][2], st[2 * s + 1][3]); afr[s] = __builtin_bit_cast(bf16x8, t); }
                bf16x8 av[2], bp[2][2];
#pragma unroll
                for (int ks = 0; ks < 2; ++ks) {
                    LAS unsigned char* vp = lds + VS_ + (32 * ks + 8 * g + q4) * VP + (16 * vt + 4 * p4) * 2;
                    av[ks] = cat8(tr16(vp), tr16(vp + 4 * VP));
#pragma unroll
                    for (int j = 0; j < 2; ++j) bp[ks][j] = *(const LAS bf16x8*)(lds + PS + (16 * (2 * dh + j) + r16) * VP + (32 * ks + 8 * g) * 2);
                }
#pragma unroll
                for (int hq = 0; hq < 2; ++hq) {
                    bf16x8 qf[2][4];
#pragma unroll
                    for (int q2 = 0; q2 < 2; ++q2)
#pragma unroll
                        for (int s = 0; s < 4; ++s) qf[q2][s] = *(const LAS bf16x8*)(lds + QS + (16 * (2 * hq + q2) + r16) * QP + (128 * dh + 32 * s + 8 * g) * 2);
                    __builtin_amdgcn_sched_barrier(0);
                    f32x4 cr[2] = {(f32x4){0.f, 0.f, 0.f, 0.f}, (f32x4){0.f, 0.f, 0.f, 0.f}};
#pragma unroll
                    for (int s = 0; s < 4; ++s)
#pragma unroll
                        for (int q2 = 0; q2 < 2; ++q2) cr[q2] = __builtin_amdgcn_mfma_f32_16x16x32_bf16(afr[s], qf[q2][s], cr[q2], 0, 0, 0);
                    part[2 * hq] = cr[0] * qd[2 * hq]; part[2 * hq + 1] = cr[1] * qd[2 * hq + 1];
                    __builtin_amdgcn_sched_barrier(0);
                }
                f32x4 ia[2] = {(f32x4){0.f, 0.f, 0.f, 0.f}, (f32x4){0.f, 0.f, 0.f, 0.f}};
#pragma unroll
                for (int ks = 0; ks < 2; ++ks)
#pragma unroll
                    for (int j = 0; j < 2; ++j) ia[j] = __builtin_amdgcn_mfma_f32_16x16x32_bf16(av[ks], bp[ks][j], ia[j], 0, 0, 0);
                if (dh == 0) { part[0] += ia[0]; part[1] += ia[1]; } else { part[2] += ia[0]; part[3] += ia[1]; }
            }
            if (dh == 1) { *(LAS f32x4*)(lds + RED + vt * 4096 + (0 * 64 + lane) * 16) = part[0]; *(LAS f32x4*)(lds + RED + vt * 4096 + (1 * 64 + lane) * 16) = part[1]; }
            else         { *(LAS f32x4*)(lds + RED + vt * 4096 + (2 * 64 + lane) * 16) = part[2]; *(LAS f32x4*)(lds + RED + vt * 4096 + (3 * 64 + lane) * 16) = part[3]; }
            {
                bf16x8 bfr[2], kf[8][2];
#pragma unroll
                for (int ks = 0; ks < 2; ++ks) { LAS unsigned char* vp = lds + VDS + (32 * ks + 8 * g + q4) * VP + (16 * vt + 4 * p4) * 2; bfr[ks] = cat8(tr16(vp), tr16(vp + 4 * VP)); }
#pragma unroll
                for (int i = 0; i < 8; ++i)
#pragma unroll
                    for (int ks = 0; ks < 2; ++ks) { LAS unsigned char* kp = lds + KS + (32 * ks + 8 * g + q4) * QP + (128 * dh + 32 * (i >> 1) + 8 * p4 + 4 * (i & 1)) * 2; kf[i][ks] = cat8(tr16(kp), tr16(kp + 4 * QP)); }
                __builtin_amdgcn_sched_barrier(0);
#pragma unroll
                for (int i = 0; i < 8; ++i) st[i] = st[i] * cd;
#pragma unroll
                for (int ks = 0; ks < 2; ++ks)
#pragma unroll
                    for (int i = 0; i < 8; ++i) st[i] = __builtin_amdgcn_mfma_f32_16x16x32_bf16(kf[i][ks], bfr[ks], st[i], 0, 0, 0);
            }
            __syncthreads();
            if (n + 1 < NCHUNK) { P2_STAGE(); if (n + 2 < NCHUNK) P2_PREFETCH(n + 2); }
            {
                const size_t tok0 = tokb + (size_t)n * CHUNK;
                f32x4 mine[2];
                mine[0] = dh == 0 ? part[0] : part[2]; mine[1] = dh == 0 ? part[1] : part[3];
#pragma unroll
                for (int q2 = 0; q2 < 2; ++q2) {
                    const int qt = 2 * dh + q2;
                    const f32x4 o = mine[q2] + *(const LAS f32x4*)(lds + RED + vt * 4096 + (qt * 64 + lane) * 16);
                    u32x2 pk; pk.x = cvtpk(o[0], o[1]); pk.y = cvtpk(o[2], o[3]);
                    *(u32x2*)(ob + (tok0 + 16 * qt + r16) * VD + h * 512 + slice * 64 + 16 * vt + 4 * g) = pk;
                    float s1 = (o[0] + o[1]) + (o[2] + o[3]), s2 = (o[0] * o[0] + o[1] * o[1]) + (o[2] * o[2] + o[3] * o[3]);
                    s1 += __shfl_xor(s1, 16); s1 += __shfl_xor(s1, 32); s2 += __shfl_xor(s2, 16); s2 += __shfl_xor(s2, 32);
                    if (g == 0) *(LAS f32x2*)(lds + SRED + ((vt * 64 + 16 * qt + r16) * 2) * 4) = (f32x2){s1, s2};
                }
            }
            __syncthreads();
            if (tid < 64) {
                const LAS float* sr = (const LAS float*)(lds + SRED);
                const float s1 = (sr[(0 * 64 + tid) * 2] + sr[(1 * 64 + tid) * 2]) + (sr[(2 * 64 + tid) * 2] + sr[(3 * 64 + tid) * 2]);
                const float s2 = (sr[(0 * 64 + tid) * 2 + 1] + sr[(1 * 64 + tid) * 2 + 1]) + (sr[(2 * 64 + tid) * 2 + 1] + sr[(3 * 64 + tid) * 2 + 1]);
                *(f32x2*)(statsP + ((tokb + (size_t)n * CHUNK + tid) * NH + h) * 16 + slice * 2) = (f32x2){s1, s2};
            }
        }
#undef P2_STAGE
#undef P2_PREFETCH
        if (false) {
            const LAS float* sr = (const LAS float*)(lds + SRED);
            const float s1 = (sr[(0 * 64 + tid) * 2] + sr[(1 * 64 + tid) * 2]) + (sr[(2 * 64 + tid) * 2] + sr[(3 * 64 + tid) * 2]);
            const float s2 = (sr[(0 * 64 + tid) * 2 + 1] + sr[(1 * 64 + tid) * 2 + 1]) + (sr[(2 * 64 + tid) * 2 + 1] + sr[(3 * 64 + tid) * 2 + 1]);
            *(f32x2*)(statsP + ((tokb + (size_t)(NCHUNK - 1) * CHUNK + tid) * NH + h) * 16 + slice * 2) = (f32x2){s1, s2};
        }
        __syncthreads();
    }
}

__device__ __forceinline__ void p3_gating(Frame& F) {
    bf16_t* ob = (bf16_t*)F.out; const bf16_t* gb = (const bf16_t*)(F.ws + WS_G); const float* stats = (const float*)(F.ws + WS_STATS);
    const int lane3 = F.ftid() & 63;
    const int gw = F.vcu * NWAVES + F.wave, NGW = F.G * NWAVES;
    for (int m = gw; m < TOK; m += NGW) {
        float sv = stats[(size_t)m * 64 + lane3];
        sv += __shfl_xor(sv, 2); sv += __shfl_xor(sv, 4); sv += __shfl_xor(sv, 8);
#pragma unroll
        for (int j = 0; j < 4; ++j) {
            const float s1 = __shfl(sv, j * 16), s2 = __shfl(sv, j * 16 + 1);
            const float mu = s1 * (1.f / DV); const float var = fmaxf(s2 * (1.f / DV) - mu * mu, 0.f); const float rstd = 1.0f / sqrtf(var + EPS);
            u32x4* op = (u32x4*)(ob + (size_t)m * VD + j * 512) + lane3; const u32x4 ov = *op; const u32x4 gv = *((const u32x4*)(gb + (size_t)m * VD + j * 512) + lane3);
            u32x4 r;
            r.x = cvt_pk_bf16(silu_f(bflo(gv.x)) * (bflo(ov.x) - mu) * rstd, silu_f(bfhi(gv.x)) * (bfhi(ov.x) - mu) * rstd);
            r.y = cvt_pk_bf16(silu_f(bflo(gv.y)) * (bflo(ov.y) - mu) * rstd, silu_f(bfhi(gv.y)) * (bfhi(ov.y) - mu) * rstd);
            r.z = cvt_pk_bf16(silu_f(bflo(gv.z)) * (bflo(ov.z) - mu) * rstd, silu_f(bfhi(gv.z)) * (bfhi(ov.z) - mu) * rstd);
            r.w = cvt_pk_bf16(silu_f(bflo(gv.w)) * (bflo(ov.w) - mu) * rstd, silu_f(bfhi(gv.w)) * (bfhi(ov.w) - mu) * rstd);
            *op = r;
        }
    }
}

__device__ __forceinline__ void p_router(Frame& F, const float* xs, const float* gain, const float* wg, const float* bg, const float* we, const float* be, int layer) {
    LAS f32x4* wgL = (LAS f32x4*)(F.lds);
    LAS f32x4* weL = (LAS f32x4*)(F.lds + 16384);
    LAS int* list = (LAS int*)(F.lds + LDS_RT_LIST);
    LAS int* lcnt = (LAS int*)(F.lds + LDS_RT_CNT);
    bf16_t* hb = (bf16_t*)(F.ws + WS_H); int* slot_tok = (int*)(F.ws + WS_SLOT_TOK); float* slot_w = (float*)(F.ws + WS_SLOT_W);
    unsigned* cntg = F.ctl + CW_CNT + layer * 32 * 64;
    const int tid = F.ftid(); const int lane = tid & 63;
    __syncthreads();
    for (int k = tid; k < DM; k += NTHREADS) { const int sl = ((k >> 8) * 4 + (k & 3)) * 64 + ((k >> 2) & 63);
        wgL[sl] = *(const f32x4*)(wg + (size_t)k * 4);
#pragma unroll
        for (int g = 0; g < 4; ++g) { weL[(g * 2 + 0) * 1024 + sl] = *(const f32x4*)(we + (size_t)k * 32 + g * 8); weL[(g * 2 + 1) * 1024 + sl] = *(const f32x4*)(we + (size_t)k * 32 + g * 8 + 4); } }
    if (tid < 64) lcnt[tid] = 0;
    __syncthreads();
    const float bg0 = bg[0], bg1 = bg[1], bg2 = bg[2], bg3 = bg[3];
    const int rows_per_blk = TOK / F.G;
    const int row_base = F.vcu * rows_per_blk;
    f32x4 vnx[4];
    { const GAS f32x4* xr0 = (const GAS f32x4*)(xs + (size_t)(row_base + F.wave) * DM) + lane;
#pragma unroll
      for (int j = 0; j < 4; ++j) vnx[j] = xr0[64 * j]; }
    for (int rr = F.wave; rr < rows_per_blk; rr += NWAVES) {
        const int m = row_base + rr;
        const GAS f32x4* gr = (const GAS f32x4*)gain + lane;
        f32x4 v[4]; float s = 0.f;
#pragma unroll
        for (int j = 0; j < 4; ++j) { v[j] = vnx[j]; s += (v[j].x * v[j].x + v[j].y * v[j].y) + (v[j].z * v[j].z + v[j].w * v[j].w); }
        if (rr + NWAVES < rows_per_blk) { const GAS f32x4* xr1 = (const GAS f32x4*)(xs + (size_t)(m + NWAVES) * DM) + lane;
#pragma unroll
            for (int j = 0; j < 4; ++j) vnx[j] = xr1[64 * j]; }
        const float inv = 1.0f / sqrtf(wave_sum_u(s) * (1.f / DM) + EPS);
        GAS u32x2* o8 = (GAS u32x2*)(hb + (size_t)m * DM) + lane;
        f32x4 gl = (f32x4){0.f, 0.f, 0.f, 0.f};
#pragma unroll
        for (int j = 0; j < 4; ++j) { const f32x4 gg = gr[64 * j]; v[j].x = v[j].x * inv * gg.x; v[j].y = v[j].y * inv * gg.y; v[j].z = v[j].z * inv * gg.z; v[j].w = v[j].w * inv * gg.w;
            u32x2 w; w.x = cvt_pk_bf16(v[j].x, v[j].y); w.y = cvt_pk_bf16(v[j].z, v[j].w); o8[64 * j] = w;
            gl += wgL[(j * 4 + 0) * 64 + lane] * v[j].x; gl += wgL[(j * 4 + 1) * 64 + lane] * v[j].y; gl += wgL[(j * 4 + 2) * 64 + lane] * v[j].z; gl += wgL[(j * 4 + 3) * 64 + lane] * v[j].w; }
        float l0 = wave_sum_u(gl.x) + bg0, l1 = wave_sum_u(gl.y) + bg1, l2 = wave_sum_u(gl.z) + bg2, l3 = wave_sum_u(gl.w) + bg3;
        int grp = 0; float lm = l0;
        if (l1 > lm) { lm = l1; grp = 1; } if (l2 > lm) { lm = l2; grp = 2; } if (l3 > lm) { lm = l3; grp = 3; }
        const float ggate = 1.0f / (expf(l0 - lm) + expf(l1 - lm) + expf(l2 - lm) + expf(l3 - lm));
        f32x4 ea = (f32x4){0.f, 0.f, 0.f, 0.f}, eb = (f32x4){0.f, 0.f, 0.f, 0.f};
        const LAS f32x4* wa = weL + (grp * 2 + 0) * 1024; const LAS f32x4* wb = weL + (grp * 2 + 1) * 1024;
#pragma unroll
        for (int j = 0; j < 4; ++j) {
            ea += wa[(j * 4 + 0) * 64 + lane] * v[j].x; eb += wb[(j * 4 + 0) * 64 + lane] * v[j].x;
            ea += wa[(j * 4 + 1) * 64 + lane] * v[j].y; eb += wb[(j * 4 + 1) * 64 + lane] * v[j].y;
            ea += wa[(j * 4 + 2) * 64 + lane] * v[j].z; eb += wb[(j * 4 + 2) * 64 + lane] * v[j].z;
            ea += wa[(j * 4 + 3) * 64 + lane] * v[j].w; eb += wb[(j * 4 + 3) * 64 + lane] * v[j].w; }
        float el[8];
        el[0] = wave_sum_u(ea.x) + be[grp * 8 + 0]; el[1] = wave_sum_u(ea.y) + be[grp * 8 + 1]; el[2] = wave_sum_u(ea.z) + be[grp * 8 + 2]; el[3] = wave_sum_u(ea.w) + be[grp * 8 + 3];
        el[4] = wave_sum_u(eb.x) + be[grp * 8 + 4]; el[5] = wave_sum_u(eb.y) + be[grp * 8 + 5]; el[6] = wave_sum_u(eb.z) + be[grp * 8 + 6]; el[7] = wave_sum_u(eb.w) + be[grp * 8 + 7];
        int i1 = 0; float m1 = el[0];
#pragma unroll
        for (int i = 1; i < 8; ++i) if (el[i] > m1) { m1 = el[i]; i1 = i; }
        int i2 = -1; float m2 = -3.0e38f;
#pragma unroll
        for (int i = 0; i < 8; ++i) if (i != i1 && el[i] > m2) { m2 = el[i]; i2 = i; }
        const float r = expf(m2 - m1); const float w1 = ggate / (1.0f + r), w2 = ggate * r / (1.0f + r);
        if (lane == 0) {
            const int e1 = grp * 8 + i1, e2 = grp * 8 + i2;
            const int r1 = __hip_atomic_fetch_add(&lcnt[e1], 1, __ATOMIC_RELAXED, __HIP_MEMORY_SCOPE_WORKGROUP), r2 = __hip_atomic_fetch_add(&lcnt[e2], 1, __ATOMIC_RELAXED, __HIP_MEMORY_SCOPE_WORKGROUP);
            list[(rr * 2 + 0) * 4 + 0] = m * 2 + 0; list[(rr * 2 + 0) * 4 + 1] = e1; list[(rr * 2 + 0) * 4 + 2] = __float_as_int(w1); list[(rr * 2 + 0) * 4 + 3] = r1;
            list[(rr * 2 + 1) * 4 + 0] = m * 2 + 1; list[(rr * 2 + 1) * 4 + 1] = e2; list[(rr * 2 + 1) * 4 + 2] = __float_as_int(w2); list[(rr * 2 + 1) * 4 + 3] = r2;
        }
    }
    __syncthreads();
    if (tid < 32) { const int c = lcnt[tid]; lcnt[32 + tid] = c > 0 ? (int)__hip_atomic_fetch_add(cntg + tid * 64, (unsigned)c, RLX_AGENT) : 0; }
    __syncthreads();
    for (int i = tid; i < rows_per_blk * 2; i += NTHREADS) {
        const int p = list[i * 4 + 0], e = list[i * 4 + 1], wbits = list[i * 4 + 2], lr = list[i * 4 + 3];
        const int slot = lcnt[32 + e] + lr;
        slot_tok[(size_t)e * TOK + slot] = p; slot_w[(size_t)e * TOK + slot] = __int_as_float(wbits);
    }
}

__device__ __forceinline__ pg8::MoeTab moe_tables(Frame& F, int layer) {
    LAS int* cnt = (LAS int*)(F.lds + LDS_MOE_TAB); LAS int* ts = cnt + 32;
    const int tid = F.ftid();
    __syncthreads();
    if (tid < 32) cnt[tid] = (int)__hip_atomic_load(F.ctl + CW_CNT + (layer * 32 + tid) * 64, RLX_AGENT);
    __syncthreads();
    if (tid == 0) { int a = 0; for (int e = 0; e < 32; ++e) { ts[e] = a; a += (cnt[e] + 255) >> 8; } ts[32] = a; }
    __syncthreads();
    pg8::MoeTab T; T.cnt = cnt; T.tstart = ts; return T;
}

template <bool FINAL>
__device__ __forceinline__ void p_combine(Frame& F, float* xs, const float* gain, float* outp) {
    const bf16_t* y0 = (const bf16_t*)(F.ws + WS_Y); const bf16_t* y1 = y0 + (size_t)TOK * DM; bf16_t* hb = (bf16_t*)(F.ws + WS_H);
    const int lane = F.ftid() & 63;
    const int gw = F.vcu * NWAVES + F.wave, NGW = F.G * NWAVES;
    for (int m = gw; m < TOK; m += NGW) {
        GAS f32x4* xr = (GAS f32x4*)(xs + (size_t)m * DM) + lane; const GAS f32x4* gr = (const GAS f32x4*)gain + lane;
        const GAS u32x2* a0 = (const GAS u32x2*)(y0 + (size_t)m * DM) + lane; const GAS u32x2* a1 = (const GAS u32x2*)(y1 + (size_t)m * DM) + lane;
        f32x4 v[4]; float s = 0.f;
#pragma unroll
        for (int j = 0; j < 4; ++j) { v[j] = xr[64 * j]; const u32x2 p0 = a0[64 * j], p1 = a1[64 * j];
            v[j].x += bflo(p0.x) + bflo(p1.x); v[j].y += bfhi(p0.x) + bfhi(p1.x); v[j].z += bflo(p0.y) + bflo(p1.y); v[j].w += bfhi(p0.y) + bfhi(p1.y);
            s += (v[j].x * v[j].x + v[j].y * v[j].y) + (v[j].z * v[j].z + v[j].w * v[j].w); }
        const float inv = 1.0f / sqrtf(wave_sum(s) * (1.f / DM) + EPS);
        if constexpr (FINAL) {
            GAS f32x4* op = (GAS f32x4*)(outp + (size_t)m * DM) + lane;
#pragma unroll
            for (int j = 0; j < 4; ++j) { const f32x4 gg = gr[64 * j]; op[64 * j] = (f32x4){v[j].x * inv * gg.x, v[j].y * inv * gg.y, v[j].z * inv * gg.z, v[j].w * inv * gg.w}; }
        } else {
            GAS u32x2* o8 = (GAS u32x2*)(hb + (size_t)m * DM) + lane;
#pragma unroll
            for (int j = 0; j < 4; ++j) { xr[64 * j] = v[j]; const f32x4 gg = gr[64 * j]; u32x2 w; w.x = cvt_pk_bf16(v[j].x * inv * gg.x, v[j].y * inv * gg.y); w.y = cvt_pk_bf16(v[j].z * inv * gg.z, v[j].w * inv * gg.w); o8[64 * j] = w; }
        }
    }
}

__device__ __forceinline__ void p_poolmix(Frame& F, const float* xs, const float* gain, float* xo) {
    constexpr int RING = 0, PT = 98304, PTP = 528;
    const bf16_t* y0 = (const bf16_t*)(F.ws + WS_Y); const bf16_t* y1 = y0 + (size_t)TOK * DM;
    const bf16_t* wp = (const bf16_t*)(F.ws + WS_WPOOL);
    LAS unsigned char* lds = F.lds;
    const int tid = F.ftid(), lane = tid & 63, g = lane >> 4, r16 = lane & 15; const int wv = F.wave;
    for (int strip = F.vcu; strip < TOK / 128; strip += F.G) {
        const int t_base = strip * 128, pos_base = t_base & (SEQ - 1);
        __syncthreads();
#pragma unroll 1
        for (int s = 0; s < 4; ++s) {
            if (s == 0 && pos_base > 0) {
#pragma unroll
                for (int it = 0; it < 2; ++it) {
                    const int rel = -16 + wv + 8 * it; const size_t m = (size_t)(t_base + rel);
                    const GAS f32x4* xr = (const GAS f32x4*)(xs + m * DM) + lane; const GAS f32x4* gr = (const GAS f32x4*)gain + lane;
                    const GAS u32x2* a0 = (const GAS u32x2*)(y0 + m * DM) + lane; const GAS u32x2* a1 = (const GAS u32x2*)(y1 + m * DM) + lane;
                    f32x4 v[4]; float ss = 0.f;
#pragma unroll
                    for (int j = 0; j < 4; ++j) { v[j] = xr[64 * j]; const u32x2 p0 = a0[64 * j], p1 = a1[64 * j];
                        v[j].x += bflo(p0.x) + bflo(p1.x); v[j].y += bfhi(p0.x) + bfhi(p1.x); v[j].z += bflo(p0.y) + bflo(p1.y); v[j].w += bfhi(p0.y) + bfhi(p1.y);
                        ss += (v[j].x * v[j].x + v[j].y * v[j].y) + (v[j].z * v[j].z + v[j].w * v[j].w); }
                    const float inv = 1.0f / sqrtf(wave_sum(ss) * (1.f / DM) + EPS);
                    const int slot = (rel + 48) % 48;
#pragma unroll
                    for (int j = 0; j < 4; ++j) { const f32x4 gg = gr[64 * j]; u32x2 w; w.x = cvt_pk_bf16(v[j].x * inv * gg.x, v[j].y * inv * gg.y); w.y = cvt_pk_bf16(v[j].z * inv * gg.z, v[j].w * inv * gg.w);
                        *(LAS u32x2*)(lds + RING + slot * 2048 + (lane + 64 * j) * 8) = w; }
                }
            }
            {
                f32x4 v[4][4]; u32x2 pa[4][4], pb[4][4];
#pragma unroll
                for (int it = 0; it < 4; ++it) { const size_t m = (size_t)(t_base + 32 * s + wv + 8 * it);
                    const GAS f32x4* xr = (const GAS f32x4*)(xs + m * DM) + lane; const GAS u32x2* a0 = (const GAS u32x2*)(y0 + m * DM) + lane; const GAS u32x2* a1 = (const GAS u32x2*)(y1 + m * DM) + lane;
#pragma unroll
                    for (int j = 0; j < 4; ++j) { v[it][j] = xr[64 * j]; pa[it][j] = a0[64 * j]; pb[it][j] = a1[64 * j]; } }
                const GAS f32x4* gr = (const GAS f32x4*)gain + lane;
#pragma unroll
                for (int it = 0; it < 4; ++it) { float ss = 0.f;
#pragma unroll
                    for (int j = 0; j < 4; ++j) { const u32x2 p0 = pa[it][j], p1 = pb[it][j];
                        v[it][j].x += bflo(p0.x) + bflo(p1.x); v[it][j].y += bfhi(p0.x) + bfhi(p1.x); v[it][j].z += bflo(p0.y) + bflo(p1.y); v[it][j].w += bfhi(p0.y) + bfhi(p1.y);
                        ss += (v[it][j].x * v[it][j].x + v[it][j].y * v[it][j].y) + (v[it][j].z * v[it][j].z + v[it][j].w * v[it][j].w); }
                    const float inv = 1.0f / sqrtf(wave_sum(ss) * (1.f / DM) + EPS);
                    const int slot = (32 * s + wv + 8 * it + 48) % 48;
#pragma unroll
                    for (int j = 0; j < 4; ++j) { const f32x4 gg = gr[64 * j]; u32x2 w; w.x = cvt_pk_bf16(v[it][j].x * inv * gg.x, v[it][j].y * inv * gg.y); w.y = cvt_pk_bf16(v[it][j].z * inv * gg.z, v[it][j].w * inv * gg.w);
                        *(LAS u32x2*)(lds + RING + slot * 2048 + (lane + 64 * j) * 8) = w; } }
            }
            __syncthreads();
#pragma unroll 1
            for (int gi = 0; gi < 4; ++gi) {
                bf16x8 bw[2][8];
#pragma unroll
                for (int nt = 0; nt < 2; ++nt)
#pragma unroll
                    for (int ks = 0; ks < 8; ++ks) bw[nt][ks] = *(const bf16x8*)(wp + (size_t)(gi * 256 + 32 * wv + 16 * nt + r16) * 256 + 32 * ks + 8 * g);
                f32x4 exv[2][2], esc[2]; u32x2 ep0[2][2], ep1[2][2];
#pragma unroll
                for (int nt = 0; nt < 2; ++nt) { const int col = gi * 256 + 32 * wv + 16 * nt + 4 * g; esc[nt] = *(const f32x4*)(F.pool_scale + col);
#pragma unroll
                    for (int mt = 0; mt < 2; ++mt) { const size_t m = (size_t)(t_base + 32 * s + 16 * mt + r16);
                        exv[mt][nt] = *(const f32x4*)(xs + m * DM + col); ep0[mt][nt] = *(const u32x2*)(y0 + m * DM + col); ep1[mt][nt] = *(const u32x2*)(y1 + m * DM + col); } }
                { const int cp = tid & 127, rq = tid >> 7; const int w = 2 << gi; const int col = gi * 256 + 2 * cp;
                  const int relf = 32 * s + 8 * rq; const int posf = pos_base + relf;
                  float s0 = 0.f, s1 = 0.f;
                  for (int d = 1; d <= w; ++d) if (posf - d >= 0) { const unsigned u = *(const LAS unsigned*)(lds + RING + ((relf - d + 48) % 48) * 2048 + col * 2); s0 += bflo(u); s1 += bfhi(u); }
#pragma unroll
                  for (int i = 0; i < 8; ++i) { const int rel = relf + i, pos = posf + i;
                      const unsigned u = *(const LAS unsigned*)(lds + RING + ((rel + 48) % 48) * 2048 + col * 2); const float h0 = bflo(u), h1 = bfhi(u); s0 += h0; s1 += h1;
                      if (pos - w >= 0) { const unsigned uo = *(const LAS unsigned*)(lds + RING + ((rel - w + 48) % 48) * 2048 + col * 2); s0 -= bflo(uo); s1 -= bfhi(uo); }
                      const float rc = 1.0f / (float)(pos + 1 < w ? pos + 1 : w);
                      *(LAS unsigned*)(lds + PT + (8 * rq + i) * PTP + cp * 4) = cvt_pk_bf16(s0 * rc - h0, s1 * rc - h1); } }
                __syncthreads();
                f32x4 acc[2][2];
#pragma unroll
                for (int mt = 0; mt < 2; ++mt)
#pragma unroll
                    for (int nt = 0; nt < 2; ++nt) acc[mt][nt] = (f32x4){0.f, 0.f, 0.f, 0.f};
#pragma unroll
                for (int ks = 0; ks < 8; ++ks)
#pragma unroll
                    for (int mt = 0; mt < 2; ++mt) { const bf16x8 ap = *(const LAS bf16x8*)(lds + PT + (16 * mt + r16) * PTP + (32 * ks + 8 * g) * 2);
#pragma unroll
                        for (int nt = 0; nt < 2; ++nt) acc[mt][nt] = __builtin_amdgcn_mfma_f32_16x16x32_bf16(bw[nt][ks], ap, acc[mt][nt], 0, 0, 0); }
#pragma unroll
                for (int mt = 0; mt < 2; ++mt)
#pragma unroll
                    for (int nt = 0; nt < 2; ++nt) { const size_t m = (size_t)(t_base + 32 * s + 16 * mt + r16); const int col = gi * 256 + 32 * wv + 16 * nt + 4 * g;
                        f32x4 xv = exv[mt][nt]; const u32x2 p0 = ep0[mt][nt], p1 = ep1[mt][nt];
                        xv.x += bflo(p0.x) + bflo(p1.x); xv.y += bfhi(p0.x) + bfhi(p1.x); xv.z += bflo(p0.y) + bflo(p1.y); xv.w += bfhi(p0.y) + bfhi(p1.y);
                        *(f32x4*)(xo + m * DM + col) = xv + acc[mt][nt] * esc[nt]; }
                __syncthreads();
            }
        }
    }
}

__device__ __forceinline__ void p_pool(Frame& F) {
    const bf16_t* hb = (const bf16_t*)(F.ws + WS_H); bf16_t* pb = (bf16_t*)(F.ws + WS_POOLED);
    const int tidp = F.ftid();
    const int c0 = tidp * 2; const int w = 2 << (c0 >> 8);
    for (int tile = F.vcu; tile < TOK / 64; tile += F.G) {
        const int t0 = tile * 64; const int pos0 = t0 & (SEQ - 1);
        float s0 = 0.f, s1 = 0.f;
        for (int d = 1; d <= w; ++d) if (pos0 - d >= 0) { const unsigned u = *(const unsigned*)(hb + (size_t)(t0 - d) * DM + c0); s0 += bflo(u); s1 += bfhi(u); }
        for (int i = 0; i < 64; ++i) {
            const int pos = pos0 + i; const unsigned u = *(const unsigned*)(hb + (size_t)(t0 + i) * DM + c0);
            const float h0 = bflo(u), h1 = bfhi(u); s0 += h0; s1 += h1;
            if (pos - w >= 0) { const unsigned uo = *(const unsigned*)(hb + (size_t)(t0 + i - w) * DM + c0); s0 -= bflo(uo); s1 -= bfhi(uo); }
            const float rc = 1.0f / (float)(pos + 1 < w ? pos + 1 : w);
            *(unsigned*)(pb + (size_t)(t0 + i) * DM + c0) = cvt_pk_bf16(s0 * rc - h0, s1 * rc - h1);
        }
    }
}

struct Args { const float* in[15]; float* out; unsigned char* ws; int ph_lo, ph_hi; };
constexpr int N_PHASES = 13;

__global__ void __launch_bounds__(NTHREADS, 2) mk_fwd(Args args) {
    extern __shared__ __attribute__((aligned(16))) unsigned char lds_raw[];
    Frame F;
    F.lds = (LAS unsigned char*)lds_raw;
    F.MISC = (volatile LAS unsigned*)(F.lds + MISC_OFF);
    F.wave = __builtin_amdgcn_readfirstlane(threadIdx.x >> 6);
    F.G = gridDim.x; { const int bx = blockIdx.x; F.vcu = (F.G % 8 == 0) ? (bx % 8) * (F.G / 8) + bx / 8 : bx; }
    F.ws = args.ws; F.out = args.out; F.ctl = (unsigned*)(args.ws + WS_CTL);
    F.x = args.in[0]; F.norm_mix = args.in[1]; F.norm_ffn = args.in[2]; F.ret_w_in = args.in[3]; F.ret_w_out = args.in[4]; F.pool_w = args.in[5]; F.pool_scale = args.in[6];
    F.moe_w_group = args.in[7]; F.moe_b_group = args.in[8]; F.moe_w_expert = args.in[9]; F.moe_b_expert = args.in[10]; F.moe_w_gate = args.in[11]; F.moe_w_up = args.in[12]; F.moe_w_down = args.in[13]; F.final_norm = args.in[14];
    for (int u = threadIdx.x; u < (LDS_BYTES - LDSCTL_OFF) / 4; u += NTHREADS) ((LAS unsigned*)(F.lds + LDSCTL_OFF))[u] = 0u;
    __syncthreads();
    XcdBarrier bar; bar.bar = (unsigned*)(F.ctl + CW_BAR); bar.x = 0; bar.st = nullptr;
#if !MK_PER_PHASE
    bar = xcd_barrier_post((unsigned*)(F.ctl + CW_BAR), F.MISC + 8);
#endif
    const int lo = args.ph_lo, hi = args.ph_hi;
#ifndef PH_MASK
#define PH_MASK 0x1fff
#endif
#define IN(k) (((PH_MASK >> (k)) & 1) && lo <= (k) && (k) < hi)
#define SEAM(k) do { if (IN(k) && IN((k) + 1)) xcd_barrier(bar); } while (0)
    float* x1 = (float*)(F.ws + WS_X1);
    bf16_t* hbuf = (bf16_t*)(F.ws + WS_H);

    if (IN(0)) { p0_prologue(F); } SEAM(0);

    if (IN(1)) {
        pg8::DenseSched S; S.init((const bf16_t*)F.out, (const bf16_t*)(F.ws + WS_WIN), DM, DM, 0, TOK, NIN, F.G, (int)blockIdx.x);
        pg8::EpiQKVG E{(bf16_t*)(F.ws + WS_Q), (bf16_t*)(F.ws + WS_K), (bf16_t*)(F.ws + WS_V), (bf16_t*)(F.ws + WS_G), (const float*)(F.ws + WS_ROPE)};
        pg8::gemm_phase<pg8::EpiQKVG, pg8::DenseSched, true>(F.lds, DM, S, E);
    } SEAM(1);

    if (IN(2)) {
        p2_retention(F);
    } SEAM(2);

    if (IN(3)) { p3_gating(F); } SEAM(3);

    if (IN(4)) {
        pg8::DenseSched S; S.init((const bf16_t*)F.out, (const bf16_t*)(F.ws + WS_WOUT), VD, VD, 0, TOK, DM, F.G, (int)blockIdx.x);
        pg8::EpiResid E{F.x, x1, nullptr};
        pg8::gemm_phase<pg8::EpiResid, pg8::DenseSched, true>(F.lds, VD, S, E);
    } SEAM(4);

#define MOE_LAYER(layer, pb, xin) do { \
        if (IN(pb)) { \
            p_router(F, (xin), F.norm_ffn + (layer) * DM, F.moe_w_group + (size_t)(layer) * DM * 4, F.moe_b_group + (layer) * 4, F.moe_w_expert + (size_t)(layer) * DM * 32, F.moe_b_expert + (layer) * 32, (layer)); \
        } SEAM(pb); \
        if (IN((pb) + 1)) { \
            const pg8::MoeTab T = moe_tables(F, (layer)); \
            pg8::EpiGateUp E{(bf16_t*)(F.ws + WS_HID)}; \
            for (int i = 0;; ++i) { \
                pg8::MoeGuSched S; S.H = hbuf; S.W = (const bf16_t*)(F.ws + WS_WGU) + (size_t)(layer) * 32 * 512 * DM; S.slot_tok = (const int*)(F.ws + WS_SLOT_TOK); S.T = T; S.L = i * F.G + F.vcu; S.lda = DM; S.ldb = DM; \
                pg8::Unit u; if (!S.next(0, u)) break; \
                pg8::gemm_phase<pg8::EpiGateUp, pg8::MoeGuSched, false>(F.lds, DM, S, E); \
            } \
        } SEAM((pb) + 1); \
        if (IN((pb) + 2)) { \
            const pg8::MoeTab T = moe_tables(F, (layer)); \
            pg8::MoeDownSched S; S.HID = (const bf16_t*)(F.ws + WS_HID); S.W = (const bf16_t*)(F.ws + WS_WD) + (size_t)(layer) * 32 * DM * DFF; S.T = T; S.G = F.G; S.c = F.vcu; S.lda = DFF; S.ldb = DFF; \
            pg8::EpiDown E{(bf16_t*)(F.ws + WS_Y), (const int*)(F.ws + WS_SLOT_TOK), (const float*)(F.ws + WS_SLOT_W), T}; \
            pg8::gemm_phase<pg8::EpiDown, pg8::MoeDownSched, true>(F.lds, DFF, S, E); \
        } SEAM((pb) + 2); \
    } while (0)

    MOE_LAYER(0, 5, x1);
    if (IN(8)) { p_poolmix(F, x1, F.norm_mix + DM, F.out); } SEAM(8);
    MOE_LAYER(1, 9, F.out);
#undef MOE_LAYER
    if (IN(12)) { p_combine<true>(F, F.out, F.final_norm, F.out); }
#undef IN
#undef SEAM
}

extern "C" void kernel_launch(void* const* d_in, const int* in_sizes, int n_in, void* d_out, int out_size, void* d_ws, size_t ws_size, hipStream_t stream) {
    static int grid = 0;
    if (grid == 0) {
        if (n_in != 15 || in_sizes[0] != TOK * DM || out_size != TOK * DM || ws_size < WS_END) { fprintf(stderr, "kernel_launch: unexpected shapes/workspace (n_in %d, ws %zu)\n", n_in, ws_size); grid = -1; return; }
        int dev = 0, cus = 0, per_cu = 0;
        if (hipGetDevice(&dev) != hipSuccess || hipDeviceGetAttribute(&cus, hipDeviceAttributeMultiprocessorCount, dev) != hipSuccess) { grid = -1; return; }
        if (hipFuncSetAttribute((const void*)mk_fwd, hipFuncAttributeMaxDynamicSharedMemorySize, LDS_BYTES) != hipSuccess) { fprintf(stderr, "kernel_launch: hipFuncSetAttribute failed\n"); grid = -1; return; }
        if (hipOccupancyMaxActiveBlocksPerMultiprocessor(&per_cu, (const void*)mk_fwd, NTHREADS, LDS_BYTES) != hipSuccess || per_cu < 1) { fprintf(stderr, "kernel_launch: occupancy query says %d blocks/CU\n", per_cu); grid = -1; (void)hipGetLastError(); return; }
        grid = cus;
        if (grid > 256) grid = 256;
    }
    if (grid < 0) return;
    if (hipMemsetAsync((char*)d_ws + WS_CTL, 0, CTL_ZERO_BYTES, stream) != hipSuccess) return;
    Args a{};
    for (int i = 0; i < 15; ++i) a.in[i] = (const float*)d_in[i];
    a.out = (float*)d_out; a.ws = (unsigned char*)d_ws;
#if MK_PER_PHASE
    for (int p = 0; p < N_PHASES; ++p) { a.ph_lo = p; a.ph_hi = p + 1; hipLaunchKernelGGL(mk_fwd, dim3(grid), dim3(NTHREADS), LDS_BYTES, stream, a); }
#else
    a.ph_lo = 0; a.ph_hi = N_PHASES;
    hipLaunchKernelGGL(mk_fwd, dim3(grid), dim3(NTHREADS), LDS_BYTES, stream, a);
#endif
}
```
